# Optimizing an MI355X kernel written in HIP

```python
import functools
import jax, jax.numpy as jnp
from jax import lax
import numpy as np

D_MODEL = 2048
BATCH = 2
SEQ = 16384
DEPTH = 4

HEAD_DIM = 128
N_HEADS = D_MODEL // HEAD_DIM
MIX_WIDTH = N_HEADS * HEAD_DIM
N_SB_HEADS = N_HEADS // 2
N_FOX_HEADS = N_HEADS - N_SB_HEADS
SB_WIDTH = N_SB_HEADS * HEAD_DIM
FOX_WIDTH = N_FOX_HEADS * HEAD_DIM
P_IN = 3 * SB_WIDTH + 4 * FOX_WIDTH + N_FOX_HEADS
D_FF = (11 * D_MODEL) // 4
N_EXPERTS = 8
TOP_K = 2
D_FF_EXPERT = D_MODEL // 2
BLOCK_Q = 128
N_QUERY_CHUNKS = 8
NORM_EPS = 1e-6

kernel_name = "hybrid_stickbreak_fox_moe_trunk"


def rmsnorm(x, g):
    xf = x.astype(jnp.float32)
    y = xf * lax.rsqrt(jnp.mean(xf * xf, axis=-1, keepdims=True) + NORM_EPS)
    return (y * g.astype(jnp.float32)).astype(x.dtype)


def head_rmsnorm(o, g):
    b, s, w = o.shape
    h = w // HEAD_DIM
    return rmsnorm(o.reshape(b, s, h, HEAD_DIM), g.reshape(h, HEAD_DIM)).reshape(b, s, w)


def split_heads(t):
    b, s, w = t.shape
    return t.reshape(b, s, w // HEAD_DIM, HEAD_DIM)


def to_query_blocks(t):
    b, s, h, d = t.shape
    return t.reshape(b, s // BLOCK_Q, BLOCK_Q, h, d).transpose(1, 0, 3, 2, 4)


def from_query_blocks(o):
    nb, b, h, q, d = o.shape
    return o.transpose(1, 0, 3, 2, 4).reshape(b, nb * q, h * d)


def causal_sweep(block_fn, per_block, s_len):
    nb = s_len // BLOCK_Q
    starts = jnp.arange(nb, dtype=jnp.int32) * BLOCK_Q
    n_chunks = min(N_QUERY_CHUNKS, nb)
    outs = []
    for c in range(n_chunks):
        b0 = (c * nb) // n_chunks
        b1 = ((c + 1) * nb) // n_chunks
        xs = tuple(a[b0:b1] for a in per_block) + (starts[b0:b1],)
        outs.append(lax.map(functools.partial(block_fn, key_len=b1 * BLOCK_Q), xs))
    return jnp.concatenate(outs, axis=0)


def stick_breaking_attention(q, k, v):
    s_len = q.shape[1]
    kh = k.transpose(0, 2, 1, 3)
    vh = v.transpose(0, 2, 1, 3)
    scale = HEAD_DIM ** -0.5
    r = jnp.arange(BLOCK_Q)
    tri_incl = (r[:, None] >= r[None, :]).astype(jnp.float32)

    def block(args, key_len):
        q_blk, t0 = args
        nk = key_len // BLOCK_Q
        kk = kh[:, :, :key_len]
        vv = vh[:, :, :key_len]
        z = jnp.einsum('bhqd,bhkd->bhqk', q_blk, kk,
                       preferred_element_type=jnp.float32) * scale
        q_pos = t0 + jnp.arange(BLOCK_Q)
        mask = jnp.arange(key_len)[None, :] < q_pos[:, None]
        sp = jnp.where(mask, jax.nn.softplus(z), 0.0)
        b, h, nq, _ = sp.shape
        sp_b = sp.reshape(b, h, nq, nk, BLOCK_Q)
        within = jnp.einsum('bhqnj,js->bhqns', sp_b, tri_incl)
        nb_idx = jnp.arange(nk)
        strict = (nb_idx[:, None] > nb_idx[None, :]).astype(jnp.float32)
        after = jnp.einsum('bhqn,nm->bhqm', jnp.sum(sp_b, axis=-1), strict)
        rev = (within + after[..., None]).reshape(b, h, nq, key_len)
        w = jnp.exp(jnp.where(mask, z - rev, -jnp.inf))
        return jnp.einsum('bhqk,bhkd->bhqd', w.astype(vv.dtype), vv)

    out = causal_sweep(block, (to_query_blocks(q),), s_len)
    return from_query_blocks(out)


def forgetting_attention(q, k, v, log_f):
    b, s_len, h, _ = q.shape
    nb = s_len // BLOCK_Q
    kh = k.transpose(0, 2, 1, 3)
    vh = v.transpose(0, 2, 1, 3)
    c = lax.cumsum(log_f, axis=1).transpose(0, 2, 1)
    c_blocks = c.reshape(b, h, nb, BLOCK_Q).transpose(2, 0, 1, 3)
    scale = HEAD_DIM ** -0.5

    def block(args, key_len):
        q_blk, c_q, t0 = args
        kk = kh[:, :, :key_len]
        vv = vh[:, :, :key_len]
        logits = jnp.einsum('bhqd,bhkd->bhqk', q_blk, kk,
                            preferred_element_type=jnp.float32) * scale
        logits = logits + c_q[..., :, None] - c[:, :, None, :key_len]
        q_pos = t0 + jnp.arange(BLOCK_Q)
        mask = jnp.arange(key_len)[None, :] <= q_pos[:, None]
        p = jax.nn.softmax(jnp.where(mask, logits, -jnp.inf), axis=-1)
        return jnp.einsum('bhqk,bhkd->bhqd', p.astype(vv.dtype), vv)

    out = causal_sweep(block, (to_query_blocks(q), c_blocks), s_len)
    return from_query_blocks(out)


def hybrid_mixer(a, w_in, b_forget, q_norm, k_norm, sb_out_norm, fox_out_norm, w_out):
    proj = a @ w_in
    offs = [SB_WIDTH, 2 * SB_WIDTH, 3 * SB_WIDTH,
            3 * SB_WIDTH + FOX_WIDTH, 3 * SB_WIDTH + 2 * FOX_WIDTH,
            3 * SB_WIDTH + 3 * FOX_WIDTH, 3 * SB_WIDTH + 4 * FOX_WIDTH]
    sb_q, sb_k, sb_v, fx_q, fx_k, fx_v, fx_g, fx_f = jnp.split(proj, offs, axis=-1)
    sb_o = stick_breaking_attention(split_heads(sb_q), split_heads(sb_k), split_heads(sb_v))
    sb_o = head_rmsnorm(sb_o, sb_out_norm)
    fq = rmsnorm(split_heads(fx_q), q_norm)
    fk = rmsnorm(split_heads(fx_k), k_norm)
    log_f = jax.nn.log_sigmoid((fx_f + b_forget).astype(jnp.float32))
    fox_o = forgetting_attention(fq, fk, split_heads(fx_v), log_f)
    fox_o = head_rmsnorm(fox_o, fox_out_norm) * jax.nn.sigmoid(fx_g)
    return jnp.concatenate([sb_o, fox_o], axis=-1) @ w_out


def swiglu(h, wg, wu, wd):
    return (jax.nn.silu(h @ wg) * (h @ wu)) @ wd


def moe_swiglu(h, router_w, wg, wu, wd):
    b, s, d = h.shape
    tokens = h.reshape(b * s, d)
    probs = jax.nn.softmax((tokens @ router_w).astype(jnp.float32), axis=-1)
    top_p, top_i = lax.top_k(probs, TOP_K)
    top_p = top_p / jnp.sum(top_p, axis=-1, keepdims=True)
    gates = jnp.sum(jax.nn.one_hot(top_i, N_EXPERTS, dtype=jnp.float32) * top_p[..., None],
                    axis=1).astype(tokens.dtype)
    y = jnp.zeros_like(tokens)
    for e in range(N_EXPERTS):
        y = y + gates[:, e:e + 1] * swiglu(tokens, wg[e], wu[e], wd[e])
    return y.reshape(b, s, d)


def setup_inputs(seed: int = 0) -> dict:
    key = jax.random.key(seed)
    ks = jax.random.split(key, 20)
    n_dense = (DEPTH + 1) // 2
    n_moe = DEPTH // 2
    nrm = jax.random.normal
    f32 = jnp.float32

    def gain(k, shape):
        return 1.0 + 0.02 * nrm(k, shape, f32)

    return {
        "x": nrm(ks[0], (BATCH, SEQ, D_MODEL), f32),
        "attn_norm": gain(ks[1], (DEPTH, D_MODEL)),
        "w_in": nrm(ks[2], (DEPTH, D_MODEL, P_IN), f32) * D_MODEL ** -0.5,
        "b_forget": 0.1 * nrm(ks[3], (DEPTH, N_FOX_HEADS), f32),
        "fox_q_norm": gain(ks[4], (DEPTH, HEAD_DIM)),
        "fox_k_norm": gain(ks[5], (DEPTH, HEAD_DIM)),
        "sb_out_norm": gain(ks[6], (DEPTH, SB_WIDTH)),
        "fox_out_norm": gain(ks[7], (DEPTH, FOX_WIDTH)),
        "w_out": nrm(ks[8], (DEPTH, MIX_WIDTH, D_MODEL), f32) * MIX_WIDTH ** -0.5,
        "ffn_norm": gain(ks[9], (DEPTH, D_MODEL)),
        "dense_w_gate": nrm(ks[10], (n_dense, D_MODEL, D_FF), f32) * D_MODEL ** -0.5,
        "dense_w_up": nrm(ks[11], (n_dense, D_MODEL, D_FF), f32) * D_MODEL ** -0.5,
        "dense_w_down": nrm(ks[12], (n_dense, D_FF, D_MODEL), f32) * D_FF ** -0.5,
        "router_w": nrm(ks[13], (n_moe, D_MODEL, N_EXPERTS), f32) * D_MODEL ** -0.5,
        "moe_w_gate": nrm(ks[14], (n_moe, N_EXPERTS, D_MODEL, D_FF_EXPERT), f32) * D_MODEL ** -0.5,
        "moe_w_up": nrm(ks[15], (n_moe, N_EXPERTS, D_MODEL, D_FF_EXPERT), f32) * D_MODEL ** -0.5,
        "moe_w_down": nrm(ks[16], (n_moe, N_EXPERTS, D_FF_EXPERT, D_MODEL), f32) * D_FF_EXPERT ** -0.5,
        "final_norm": gain(ks[17], (D_MODEL,)),
    }


def reference(x, attn_norm, w_in, b_forget, fox_q_norm, fox_k_norm, sb_out_norm,
              fox_out_norm, w_out, ffn_norm, dense_w_gate, dense_w_up, dense_w_down,
              router_w, moe_w_gate, moe_w_up, moe_w_down, final_norm):
    h = x
    for layer in range(DEPTH):
        a = rmsnorm(h, attn_norm[layer])
        h = h + hybrid_mixer(a, w_in[layer], b_forget[layer], fox_q_norm[layer],
                             fox_k_norm[layer], sb_out_norm[layer], fox_out_norm[layer],
                             w_out[layer])
        m = rmsnorm(h, ffn_norm[layer])
        i = layer // 2
        if layer % 2 == 0:
            h = h + swiglu(m, dense_w_gate[i], dense_w_up[i], dense_w_down[i])
        else:
            h = h + moe_swiglu(m, router_w[i], moe_w_gate[i], moe_w_up[i], moe_w_down[i])
    return rmsnorm(h, final_norm)
```

```cpp
#include <hip/hip_runtime.h>
#include <cstdio>
#include <cstdint>

#ifndef GU_MODE
#define GU_MODE 2
#endif
#ifndef G2_MODE
#define G2_MODE 2
#endif
#ifndef G1_MODE
#define G1_MODE 2
#endif
#define DI __device__ __forceinline__
#define LAS __attribute__((address_space(3)))
#define GAS __attribute__((address_space(1)))

typedef unsigned short bf16_t;
typedef short bf16x8 __attribute__((ext_vector_type(8)));
typedef short s16x4 __attribute__((ext_vector_type(4)));
typedef float f32x4 __attribute__((ext_vector_type(4)));
typedef float f32x2 __attribute__((ext_vector_type(2)));
typedef float f32x16 __attribute__((ext_vector_type(16)));
typedef unsigned u32x4 __attribute__((ext_vector_type(4)));
typedef unsigned u32x2 __attribute__((ext_vector_type(2)));
typedef __bf16 bf16x2_t __attribute__((ext_vector_type(2)));
typedef unsigned long long u64;
typedef int i32x8 __attribute__((ext_vector_type(8)));
typedef int i32x4 __attribute__((ext_vector_type(4)));

constexpr int DM = 2048, NBATCH = 2, SEQ = 16384, MTOK = NBATCH * SEQ, NLAYER = 4, HD = 128;
constexpr int PROJ_N = 7168, P_IN = 7176, DFF = 5632, NE = 8, DFE = 1024;
constexpr float NORM_EPS = 1e-6f;
constexpr float LOG2E = 1.4426950408889634f;
constexpr float QK_SCALE2 = 0.08838834764831845f * 1.4426950408889634f;
constexpr float RS_FIX = 16777216.0f;
constexpr float RS_INV = 1.0f / (16777216.0f * 2048.0f);
constexpr float F8_SA = 8.0f, F8_SW = 1024.0f, F8_SACT = 16.0f;
constexpr float MIX_R = 4.0f;
constexpr float Q8_R = 5.0f;
constexpr float SB_EXIT2 = 24.0f;
constexpr float FOX_EXIT2 = 38.0f;

constexpr size_t MiB = 1u << 20;
constexpr size_t WS_CTL = 0, CTL_ZERO_BYTES = 4 * MiB;
constexpr int CW_TMO = 0;
constexpr int CW_BAR = 4096;
constexpr int CW_PAIRCNT = 20480;
constexpr int CW_MOECNT = 16384;
constexpr size_t WS_ROWSS = 1 * MiB;
constexpr size_t WS_WMAX = 3 * MiB + 512 * 1024;
constexpr int WMAX_IN = 0, WMAX_GU = 8192, WMAX_OUT = 24576, WMAX_LAYER = 32768;
constexpr size_t WS_HB = 4 * MiB;
constexpr size_t WS_PROJ = WS_HB + 128 * MiB;
constexpr size_t WS_MIX = WS_PROJ + 448 * MiB;
constexpr size_t WS_WBUF = WS_MIX + 128 * MiB;
constexpr size_t WSLOT = 134 * MiB;
constexpr size_t WO_WIN = 0, WO_WF = 28 * MiB, WO_WR = 28 * MiB + 65536, WO_WOUT = 29 * MiB, WO_FFN_GU = 37 * MiB, WO_DENSE_D = 81 * MiB, WO_MOE_D = 101 * MiB;
constexpr size_t WS_LOGF = WS_WBUF + 2 * WSLOT;
constexpr size_t WS_SSQ = WS_LOGF + 1 * MiB;
constexpr size_t WS_TOK = WS_SSQ + 8 * MiB;
constexpr size_t WS_GATE = WS_TOK + 2 * MiB;
constexpr size_t WS_HB8 = WS_GATE + 2 * MiB;
constexpr size_t WS_XACC = WS_HB8 + 64 * MiB;
constexpr size_t XPLANE = (size_t)MTOK * 8, XSLOT = 8 * XPLANE;
constexpr float XFIX = 262144.0f;
constexpr size_t WS_RSL = WS_XACC + 6 * XSLOT * 4;
constexpr size_t WS_PTOK = WS_RSL + 2 * MiB;
constexpr size_t WS_PREFA = WS_PTOK + 4 * MiB, WS_PREFB = WS_PREFA + 4 * MiB;
constexpr size_t WS_END = WS_PREFB + 4 * MiB;

constexpr int ACT_MOE_ROWS = 2 * MTOK + 16 * 256;

constexpr int RING_BYTES = 131072;
constexpr int ATT_WAVE_BYTES = 8192 + 8192 + 256;
constexpr int SCRATCH_BYTES = 145408;
constexpr int LCTL_OFF = SCRATCH_BYTES;
constexpr int LDS_BYTES = 147456;
constexpr int XLDS_OFF = RING_BYTES;
static_assert(LCTL_OFF + 1024 <= LDS_BYTES, "LDS map");
constexpr int LC_BAR = 0;
constexpr int LC_MOE = 16;
constexpr int LC_RT = 96;
constexpr int LC_PAIR = 160;
constexpr int LC_RT2 = 240;
constexpr int NPAIR = 28;
DI int pair_id(int a, int b) { return a * (15 - a) / 2 + b - a - 1; }

DI unsigned cvtpk(float lo, float hi) { f32x2 v = {lo, hi}; bf16x2_t b = __builtin_convertvector(v, bf16x2_t); return __builtin_bit_cast(unsigned, b); }
DI unsigned pk4_fp8(float a, float b, float c, float d) {
    a = __builtin_fminf(__builtin_fmaxf(a, -448.f), 448.f); b = __builtin_fminf(__builtin_fmaxf(b, -448.f), 448.f); c = __builtin_fminf(__builtin_fmaxf(c, -448.f), 448.f); d = __builtin_fminf(__builtin_fmaxf(d, -448.f), 448.f);
    int w = __builtin_amdgcn_cvt_pk_fp8_f32(a, b, 0, false); w = __builtin_amdgcn_cvt_pk_fp8_f32(c, d, w, true); return (unsigned)w; }
DI unsigned pk4_q8(float a, float b, float c, float d) {
    unsigned w = 0; w = __builtin_amdgcn_cvt_pk_u8_f32(__builtin_fmaxf(a + 128.0f, 1.0f), 0, w); w = __builtin_amdgcn_cvt_pk_u8_f32(__builtin_fmaxf(b + 128.0f, 1.0f), 1, w);
    w = __builtin_amdgcn_cvt_pk_u8_f32(__builtin_fmaxf(c + 128.0f, 1.0f), 2, w); w = __builtin_amdgcn_cvt_pk_u8_f32(__builtin_fmaxf(d + 128.0f, 1.0f), 3, w); return w ^ 0x80808080u; }
DI float i2f(float bits) { return (float)__float_as_int(bits); }
DI float bf2f(unsigned short u) { return __uint_as_float((unsigned)u << 16); }
DI float rs_from(u64 v) { return __builtin_amdgcn_rsqf((float)v * RS_INV + NORM_EPS); }
DI float fast_exp2(float x) { return __builtin_amdgcn_exp2f(x); }
DI float fast_log2(float x) { return __builtin_amdgcn_logf(x); }
DI float fast_rcp(float x) { return __builtin_amdgcn_rcpf(x); }
DI float sigmoidf_(float x) { return fast_rcp(1.0f + fast_exp2(-x * LOG2E)); }
DI float wave_sum(float v) {
#pragma unroll
    for (int o = 1; o < 64; o <<= 1) v += __shfl_xor(v, o);
    return v;
}
DI float wave_max(float v) {
#pragma unroll
    for (int o = 1; o < 64; o <<= 1) v = fmaxf(v, __shfl_xor(v, o));
    return v;
}

namespace pg8 {
constexpr int BM = 256, BK = 64, HALF = 128, HTB = HALF * BK * 2, STAGE_BYTES = 8 * HTB, NXCD = 8, WGM = 8;
__host__ __device__ __forceinline__ int lds_byte(int r, int c) { const int st = (r >> 4) * 2 + (c >> 5), rr = r & 15, cc = c & 31, ob = rr * 64 + cc * 2; return st * 1024 + (ob ^ (((ob >> 9) & 1) << 5)); }
__host__ __device__ __forceinline__ void stage_rc(int b, int& R, int& C) { const int st = b / 1024, sb = b % 1024, swz = sb ^ (((sb >> 9) & 1) << 5); R = (st >> 1) * 16 + swz / 64; C = (st & 1) * 32 + (swz % 64) / 2; }
__host__ __device__ __forceinline__ int perm32(int rho) { const int n = rho >> 4, i = rho & 15; return 8 * (i >> 2) + 4 * n + (i & 3); }

struct Unit { int pm, pn, c, lt, valid; };

DI bool order_next(int i, int G, int c, int nM, int nN, int& pm, int& pn) {
    const int nwg = nM * nN; const long L = (long)i * G + c; if (L >= nwg) return false;
    int wgid = (int)L; { const int q = nwg / NXCD, r = nwg % NXCD, xcd = wgid % NXCD, off = wgid / NXCD; wgid = (xcd < r ? xcd * (q + 1) : r * (q + 1) + (xcd - r) * q) + off; }
    const int nig = WGM * nN, gid = wgid / nig, fm = gid * WGM, gsz = (nM - fm) < WGM ? (nM - fm) : WGM;
    pm = fm + ((wgid % nig) % gsz); pn = (wgid % nig) / gsz; return true;
}
struct DenseSched {
    static constexpr bool GATHER = false, DUAL = false;
    const char* A; const char* Bt; int nM, nN, G, c; size_t tstep;
    DI bool next(int i, Unit& u) const { u.c = 0; u.lt = 0; u.valid = 256; return order_next(i, G, c, nM, nN, u.pm, u.pn); }
    DI const char* a_base(const Unit& u) const { return A + (size_t)u.pm * tstep; }
    DI const char* b_base(const Unit& u) const { return Bt + (size_t)u.pn * tstep; }
    DI void a_offs(const Unit&, int, unsigned (&)[2][2]) const {}
};
template <bool GATHER_> struct MoeSched {
    static constexpr bool GATHER = GATHER_; static constexpr bool DUAL = false;
    const char* A; const char* Bt; const LAS int* tab; const int* tok; int c0, nc, G, c; size_t tstepA, tstepB, estrideB; unsigned rowbytes;
    DI bool next(int i, Unit& u) const {
        const int NT = tab[16 + nc]; int T, pn;
        if (!order_next(i, G, c, NT, 8, T, pn)) return false;
        int cc = 0;
        for (int j = 1; j < nc; ++j) if (T >= tab[16 + j]) cc = j;
        const int lt = T - tab[16 + cc]; const int cnt = tab[c0 + cc];
        u.c = __builtin_amdgcn_readfirstlane(c0 + cc); u.lt = __builtin_amdgcn_readfirstlane(lt); u.valid = __builtin_amdgcn_readfirstlane(min(256, cnt - lt * 256));
        u.pm = __builtin_amdgcn_readfirstlane(tab[33 + c0 + cc] + lt); u.pn = __builtin_amdgcn_readfirstlane(pn); return true;
    }
    DI const char* a_base(const Unit& u) const { return GATHER ? A : A + (size_t)u.pm * tstepA; }
    DI const char* b_base(const Unit& u) const { return Bt + (size_t)(u.c & 7) * estrideB + (size_t)u.pn * tstepB; }
    DI void a_offs(const Unit& u, int tid, unsigned (&off)[2][2]) const {
        asm volatile("" : "+v"(tid)); int R, C; stage_rc(tid * 16, R, C);
#pragma unroll
        for (int h = 0; h < 2; ++h)
#pragma unroll
            for (int i = 0; i < 2; ++i) { const int r = h * HALF + R + 64 * i; const int rr = r < u.valid ? r : 0; const int t = tok[(size_t)u.c * MTOK + u.lt * 256 + rr]; off[h][i] = (unsigned)t * rowbytes + (unsigned)(C * 2); }
    }
};

struct PairSched {
    static constexpr bool GATHER = true, DUAL = true;
    const char* A; const char* Bt; const LAS int* tab; const LAS int* tab2; const int* prefA; const int* prefB; int G, c; size_t tstepB, estrideB; unsigned rowbytes;
    DI bool next(int i, Unit& u) const {
        const int NT = tab2[32 + NPAIR]; int T, pn;
        if (!order_next(i, G, c, NT, 8, T, pn)) return false;
        int cc = 0;
        for (int j = 1; j < NPAIR; ++j) if (T >= tab2[32 + j]) cc = j;
        const int lt = T - tab2[32 + cc]; const int cnt = tab2[cc];
        u.c = __builtin_amdgcn_readfirstlane(cc); u.lt = __builtin_amdgcn_readfirstlane(lt); u.valid = __builtin_amdgcn_readfirstlane(min(256, cnt - lt * 256));
        u.pm = 0; u.pn = __builtin_amdgcn_readfirstlane(pn); return true;
    }
    DI int ea(const Unit& u) const { int a = 0; for (int j = 1; j < 7; ++j) if (u.c >= j * (15 - j) / 2) a = j; return a; }
    DI const char* a_base(const Unit&) const { return A; }
    DI const char* b_base(const Unit& u) const { return Bt + (size_t)ea(u) * estrideB + (size_t)u.pn * tstepB; }
    DI const char* b_base2(const Unit& u) const { const int a = ea(u); const int b = u.c - a * (15 - a) / 2 + a + 1; return Bt + (size_t)b * estrideB + (size_t)u.pn * tstepB; }
    DI void a_offs(const Unit& u, int tid, unsigned (&off)[2][2], unsigned (&off2)[2][2]) const {
        asm volatile("" : "+v"(tid)); int R, C; stage_rc(tid * 16, R, C);
        int ra[2][2], rb[2][2];
#pragma unroll
        for (int h = 0; h < 2; ++h)
#pragma unroll
            for (int i = 0; i < 2; ++i) { const int r = h * HALF + R + 64 * i; const int rr = r < u.valid ? r : 0; const size_t li = (size_t)u.c * MTOK + u.lt * 256 + rr; ra[h][i] = prefA[li]; rb[h][i] = prefB[li]; }
#pragma unroll
        for (int h = 0; h < 2; ++h)
#pragma unroll
            for (int i = 0; i < 2; ++i) { off[h][i] = (unsigned)(tab[33 + (ra[h][i] >> 15)] * 256 + (ra[h][i] & 32767)) * rowbytes + (unsigned)(C * 2); off2[h][i] = (unsigned)(tab[33 + (rb[h][i] >> 15)] * 256 + (rb[h][i] & 32767)) * rowbytes + (unsigned)(C * 2); }
    }
};

template <class Epi, class Sched, int MODE = 0>
DI void gemm_phase(LAS unsigned char* lds, const int KB, const Sched& S, const Epi& E) {
    int tid = threadIdx.x; asm volatile("" : "+v"(tid));
    const int wid = __builtin_amdgcn_readfirstlane(tid >> 6), lane = tid & 63, wr = wid >> 2, wc = wid & 3, fr = lane & 15, fq = lane >> 4;
    const int nt = (Sched::DUAL ? 2 : 1) * (KB / 128);
    unsigned voffA, voffB;
    { int R, C; stage_rc(tid * 16, R, C); const int Rb = Epi::COLMAP ? (64 * (R >> 5) + perm32(R & 31)) : (Epi::PERM ? ((R & ~31) + perm32(R & 31)) : R); voffA = (unsigned)(R * KB + C * 2); voffB = (unsigned)(Rb * KB + C * 2); }
    const size_t pstep = (size_t)64 * KB;
    const size_t pstepB = Epi::COLMAP ? (size_t)128 * KB : (size_t)64 * KB, hstepB = Epi::COLMAP ? (size_t)32 * KB : (size_t)HALF * KB;
    const size_t kstep = (size_t)(BK * 2);
    const size_t hstep = (size_t)HALF * KB;
    const unsigned ldsw = (unsigned)wid * 1024u;
    const int aoff = lds_byte(wr * 64 + fr, fq * 8), boff = lds_byte(wc * 32 + fr, fq * 8);
    unsigned offC[2][2] = {{0u, 0u}, {0u, 0u}}, offN[2][2] = {{0u, 0u}, {0u, 0u}};
    unsigned offC2[2][2] = {{0u, 0u}, {0u, 0u}}, offN2[2][2] = {{0u, 0u}, {0u, 0u}}; (void)offC2; (void)offN2;
#define PG8_SA(b, h) (((b) * 2 + (h)) * HTB)
#define PG8_SB(b, h) ((4 + (b) * 2 + (h)) * HTB)
#define PG8_STAGE(bufoff, gbase, voff) do { _Pragma("unroll") for (int _i = 0; _i < 2; ++_i) \
        __builtin_amdgcn_global_load_lds((const unsigned*)((const char*)(gbase) + _i * pstep + (voff)), (LAS unsigned*)(lds + (bufoff) + ldsw + _i * 8192), 16, 0, 0); } while (0)
#define PG8_STAGE_B(b, h, ptr) do { _Pragma("unroll") for (int _i = 0; _i < 2; ++_i) \
        __builtin_amdgcn_global_load_lds((const unsigned*)((const char*)(ptr) + (h) * hstepB + _i * pstepB + voffB), (LAS unsigned*)(lds + PG8_SB(b, h) + ldsw + _i * 8192), 16, 0, 0); } while (0)
#define PG8_STAGE_G(bufoff, gbase, voff) do { _Pragma("unroll") for (int _i = 0; _i < 2; ++_i) \
        __builtin_amdgcn_global_load_lds((const unsigned*)((const char*)(gbase) + (voff)[_i]), (LAS unsigned*)(lds + (bufoff) + ldsw + _i * 8192), 16, 0, 0); } while (0)
#define PG8_STAGE_A(b, h, ptr, sel) do { if constexpr (Sched::GATHER) { const int _s = (int)(sel); unsigned _o[2] = { _s == 1 ? offN[h][0] : (_s == 2 ? offC2[h][0] : offC[h][0]), _s == 1 ? offN[h][1] : (_s == 2 ? offC2[h][1] : offC[h][1]) }; PG8_STAGE_G(PG8_SA(b, h), ptr, _o); } \
        else { PG8_STAGE(PG8_SA(b, h), (ptr) + (h) * hstep, voffA); } } while (0)
#define PG8_LDA(dst, b, h) do { _Pragma("unroll") for (int m = 0; m < 4; ++m) _Pragma("unroll") for (int k = 0; k < 2; ++k) dst[m][k] = *(const LAS bf16x8*)(lds + PG8_SA(b, h) + aoff + m * 2048 + k * 1024); } while (0)
#define PG8_LDB(dst, b, h) do { _Pragma("unroll") for (int n = 0; n < 2; ++n) _Pragma("unroll") for (int k = 0; k < 2; ++k) dst[n][k] = *(const LAS bf16x8*)(lds + PG8_SB(b, h) + boff + n * 2048 + k * 1024); } while (0)
#define PG8_CAT(x) __builtin_shufflevector(__builtin_bit_cast(i32x4, (x)[0]), __builtin_bit_cast(i32x4, (x)[1]), 0, 1, 2, 3, 4, 5, 6, 7)
#define PG8_MMA(ai, bj, At, Bt) do { __builtin_amdgcn_s_setprio(1); _Pragma("unroll") for (int m = 0; m < 4; ++m) _Pragma("unroll") for (int n = 0; n < 2; ++n) { \
        if constexpr (MODE == 1) { const i32x8 _b = PG8_CAT(Bt[n]), _a = PG8_CAT(At[m]); asm volatile("v_mfma_f32_16x16x128_f8f6f4 %0, %1, %2, %0" : "+v"(acc[ai][bj][m][n]) : "v"(_b), "v"(_a)); } \
        else if constexpr (MODE == 2) { _Pragma("unroll") for (int k = 0; k < 2; ++k) acc[ai][bj][m][n] = __builtin_bit_cast(f32x4, __builtin_amdgcn_mfma_i32_16x16x64_i8(__builtin_bit_cast(i32x4, Bt[n][k]), __builtin_bit_cast(i32x4, At[m][k]), __builtin_bit_cast(i32x4, acc[ai][bj][m][n]), 0, 0, 0)); } \
        else { _Pragma("unroll") for (int k = 0; k < 2; ++k) acc[ai][bj][m][n] = __builtin_amdgcn_mfma_f32_16x16x32_bf16(Bt[n][k], At[m][k], acc[ai][bj][m][n], 0, 0, 0); } } \
        __builtin_amdgcn_s_setprio(0); } while (0)
#define PG8_WAIT_V(n) asm volatile("s_waitcnt vmcnt(" #n ")" ::: "memory")
#define PG8_WAIT_L(n) asm volatile("s_waitcnt lgkmcnt(" #n ")" ::: "memory")
#define PG8_BAR __builtin_amdgcn_s_barrier()
#define PG8_SCHED __builtin_amdgcn_sched_barrier(0)
    Unit cur, nxt; int ui = 0;
    if (!S.next(0, cur)) return;
    f32x4 acc[2][2][4][2];
#pragma unroll
    for (int a = 0; a < 2; ++a)
#pragma unroll
        for (int b = 0; b < 2; ++b)
#pragma unroll
            for (int m = 0; m < 4; ++m)
#pragma unroll
                for (int n = 0; n < 2; ++n) acc[a][b][m][n] = (f32x4){0.f, 0.f, 0.f, 0.f};
    bf16x8 At[4][2], B0[2][2], B1[2][2];
    const char* cA = S.a_base(cur); const char* cB = S.b_base(cur); const char* cB2 = cB; const char* nB2 = cB; (void)cB2; (void)nB2;
    if constexpr (Sched::DUAL) { S.a_offs(cur, tid, offC, offC2); cB2 = S.b_base2(cur); }
    else if constexpr (Sched::GATHER) S.a_offs(cur, tid, offC);
    PG8_STAGE_B(0, 0, cB); PG8_STAGE_B(0, 1, cB); PG8_STAGE_A(0, 0, cA, false); PG8_STAGE_A(0, 1, cA, false);
    if (wr == 1) PG8_BAR;
    PG8_WAIT_V(2); PG8_BAR;
    PG8_STAGE_B(1, 0, cB + kstep); PG8_STAGE_A(1, 0, cA + kstep, false); PG8_STAGE_B(1, 1, cB + kstep);
    PG8_WAIT_V(6); PG8_BAR;
    for (;;) {
        const bool has_next = S.next(ui + 1, nxt);
        const char* nA = has_next ? S.a_base(nxt) : cA; const char* nB = has_next ? S.b_base(nxt) : cB;
        if constexpr (Sched::DUAL) {
            if (has_next) { S.a_offs(nxt, tid, offN, offN2); nB2 = S.b_base2(nxt); }
            else { nB2 = cB2;
#pragma unroll
                for (int h = 0; h < 2; ++h)
#pragma unroll
                    for (int i = 0; i < 2; ++i) { offN[h][i] = offC[h][i]; offN2[h][i] = offC2[h][i]; } }
        } else if constexpr (Sched::GATHER) {
            if (has_next) S.a_offs(nxt, tid, offN);
            else {
#pragma unroll
                for (int h = 0; h < 2; ++h)
#pragma unroll
                    for (int i = 0; i < 2; ++i) offN[h][i] = offC[h][i]; }
        }
        for (int t = 0; t < nt; t += 2) {
            const bool last = (t == nt - 2);
            const int hh = nt >> 1; const bool h1 = Sched::DUAL && (t + 1 >= hh), h2 = Sched::DUAL && (t + 2 >= hh);
            const int s1 = h1 ? 2 : 0, s2 = last ? 1 : (h2 ? 2 : 0);
            const char* a1 = cA + (size_t)(t + 1 - (h1 ? hh : 0)) * kstep;
            const char* a2 = last ? nA : cA + (size_t)(t + 2 - (h2 ? hh : 0)) * kstep; const char* b2 = last ? nB : (h2 ? cB2 : cB) + (size_t)(t + 2 - (h2 ? hh : 0)) * kstep;
            const char* a3 = a2 + kstep; const char* b3 = b2 + kstep;
            PG8_LDB(B0, 0, 0); PG8_LDB(B1, 0, 1); PG8_SCHED; PG8_LDA(At, 0, 0); PG8_STAGE_A(1, 1, a1, s1);
            PG8_WAIT_V(8); PG8_WAIT_L(0); PG8_BAR; PG8_MMA(0, 0, At, B0); PG8_MMA(0, 1, At, B1); PG8_BAR; PG8_SCHED;
            PG8_LDA(At, 0, 1); PG8_STAGE_B(0, 0, b2); PG8_STAGE_B(0, 1, b2); PG8_STAGE_A(0, 0, a2, s2);
            PG8_WAIT_V(8); PG8_WAIT_L(0); PG8_BAR; PG8_MMA(1, 0, At, B0); PG8_MMA(1, 1, At, B1); PG8_BAR; PG8_SCHED;
            PG8_LDB(B0, 1, 0); PG8_LDB(B1, 1, 1); PG8_SCHED; PG8_LDA(At, 1, 0); PG8_STAGE_A(0, 1, a2, s2);
            PG8_WAIT_V(8); PG8_WAIT_L(0); PG8_BAR; PG8_MMA(0, 0, At, B0); PG8_MMA(0, 1, At, B1); PG8_BAR; PG8_SCHED;
            PG8_LDA(At, 1, 1); PG8_STAGE_B(1, 0, b3); PG8_STAGE_B(1, 1, b3); PG8_STAGE_A(1, 0, a3, s2);
            PG8_WAIT_V(8); PG8_WAIT_L(0); PG8_BAR; PG8_MMA(1, 0, At, B0); PG8_MMA(1, 1, At, B1); PG8_BAR; PG8_SCHED;
        }
        if (wr == 0) PG8_BAR;
        if constexpr (MODE == 1) asm volatile("s_nop 15\n\ts_nop 15" ::: "memory");
        { int t2 = tid; asm volatile("" : "+v"(t2)); const int l2 = t2 & 63, w2 = __builtin_amdgcn_readfirstlane(t2 >> 6); E(acc, cur, w2 >> 2, w2 & 3, l2 & 15, l2 >> 4); }
        if (!has_next) break;
#pragma unroll
        for (int a = 0; a < 2; ++a)
#pragma unroll
            for (int b = 0; b < 2; ++b)
#pragma unroll
                for (int m = 0; m < 4; ++m)
#pragma unroll
                    for (int n = 0; n < 2; ++n) acc[a][b][m][n] = (f32x4){0.f, 0.f, 0.f, 0.f};
        cur = nxt; cA = nA; cB = nB; ++ui;
        if constexpr (Sched::DUAL) cB2 = nB2;
        if constexpr (Sched::GATHER) {
#pragma unroll
            for (int h = 0; h < 2; ++h)
#pragma unroll
                for (int i = 0; i < 2; ++i) { offC[h][i] = offN[h][i]; if constexpr (Sched::DUAL) offC2[h][i] = offN2[h][i]; } }
        if (wr == 1) PG8_BAR;
    }
    PG8_WAIT_V(0);
    PG8_BAR;
#undef PG8_SA
#undef PG8_SB
#undef PG8_STAGE
#undef PG8_STAGE_A
#undef PG8_STAGE_G
#undef PG8_STAGE_B
#undef PG8_LDA
#undef PG8_LDB
#undef PG8_MMA
#undef PG8_CAT
#undef PG8_WAIT_V
#undef PG8_WAIT_L
#undef PG8_BAR
#undef PG8_SCHED
}

template <int MODE> struct EpiProj {
    static constexpr bool PERM = true, COLMAP = true;
    bf16_t* proj; const u64* rowss; float* ssq; const float* gq; const float* gk; const u64* rowss_q; const float* wmax;
    DI void operator()(const f32x4 (&acc)[2][2][4][2], const Unit& u, int wr, int wc, int fr, int fq) const {
        const int row0 = u.pm * BM + wr * 64 + fr; const int tcol = wc * 64 + 8 * fq;
        const int dcol = (wc & 1) * 64 + 8 * fq;
        const int pn = u.pn; const int kind = pn < 4 ? 0 : (pn < 12 ? 1 : (pn < 20 ? 2 : (pn < 24 ? 1 : 3)));
        const int hidx = ((pn < 16) ? (pn - 12) * 2 : 8 + (pn - 16) * 2) + (wc >> 1);
        u64 rv[2][4], rq[2][4];
#pragma unroll
        for (int ai = 0; ai < 2; ++ai)
#pragma unroll
            for (int m = 0; m < 4; ++m) { rv[ai][m] = rowss[row0 + ai * HALF + m * 16]; if (MODE == 2) rq[ai][m] = rowss_q[row0 + ai * HALF + m * 16]; }
        f32x4 g[2][2] = {{{1.f, 1.f, 1.f, 1.f}, {1.f, 1.f, 1.f, 1.f}}, {{1.f, 1.f, 1.f, 1.f}, {1.f, 1.f, 1.f, 1.f}}};
        if (kind == 2) { const float* gp = (pn < 16) ? gq : gk;
#pragma unroll
            for (int bj = 0; bj < 2; ++bj) { g[bj][0] = *(const f32x4*)(gp + dcol + 32 * bj); g[bj][1] = *(const f32x4*)(gp + dcol + 32 * bj + 4); } }
        f32x4 wi[2][2] = {{{1.f, 1.f, 1.f, 1.f}, {1.f, 1.f, 1.f, 1.f}}, {{1.f, 1.f, 1.f, 1.f}, {1.f, 1.f, 1.f, 1.f}}};
        if (MODE == 2) { const float* wm = wmax + pn * BM + tcol;
#pragma unroll
            for (int bj = 0; bj < 2; ++bj) { wi[bj][0] = *(const f32x4*)(wm + 32 * bj); wi[bj][1] = *(const f32x4*)(wm + 32 * bj + 4); }
            asm volatile("" ::: "memory");
#pragma unroll
            for (int bj = 0; bj < 2; ++bj) { wi[bj][0] = wi[bj][0] * (1.0f / 127.0f); wi[bj][1] = wi[bj][1] * (1.0f / 127.0f); } }
#pragma unroll
        for (int ai = 0; ai < 2; ++ai)
#pragma unroll
            for (int m = 0; m < 4; ++m) {
                const int row = row0 + ai * HALF + m * 16;
                float rs = rs_from(rv[ai][m]); if (kind == 0) rs *= QK_SCALE2;
                if (MODE == 2) rs *= (Q8_R / 127.0f) / rs_from(rq[ai][m]);
                bf16_t* rowp = proj + (size_t)row * PROJ_N + pn * BM + tcol;
#pragma unroll
                for (int bj = 0; bj < 2; ++bj) {
                    f32x4 v0, v1;
                    if (MODE == 2) {
#pragma unroll
                        for (int k = 0; k < 4; ++k) { v0[k] = i2f(acc[ai][bj][m][0][k]) * wi[bj][0][k]; v1[k] = i2f(acc[ai][bj][m][1][k]) * wi[bj][1][k]; }
                    } else { v0 = acc[ai][bj][m][0]; v1 = acc[ai][bj][m][1]; }
                    v0 = v0 * rs; v1 = v1 * rs;
                    if (kind == 2) {
                        float ss = (v0[0] * v0[0] + v0[1] * v0[1]) + (v0[2] * v0[2] + v0[3] * v0[3]) + (v1[0] * v1[0] + v1[1] * v1[1]) + (v1[2] * v1[2] + v1[3] * v1[3]);
                        ss += __shfl_xor(ss, 16); ss += __shfl_xor(ss, 32);
                        if (fq == 0) ssq[((size_t)row * 16 + hidx) * 4 + (wc & 1) * 2 + bj] = ss;
                        v0 = v0 * g[bj][0]; v1 = v1 * g[bj][1];
                    } else if (kind == 3) {
#pragma unroll
                        for (int k = 0; k < 4; ++k) { v0[k] = sigmoidf_(v0[k]); v1[k] = sigmoidf_(v1[k]); }
                    }
                    u32x4 w; w.x = cvtpk(v0[0], v0[1]); w.y = cvtpk(v0[2], v0[3]); w.z = cvtpk(v1[0], v1[1]); w.w = cvtpk(v1[2], v1[3]);
                    *(u32x4*)(rowp + bj * 32) = w;
                }
            }
    }
};
DI u32x2 bf8x8(const u32x4& w) {
    u32x2 o; o.x = pk4_fp8(__uint_as_float(w.x << 16) * F8_SA, __uint_as_float(w.x & 0xffff0000u) * F8_SA, __uint_as_float(w.y << 16) * F8_SA, __uint_as_float(w.y & 0xffff0000u) * F8_SA);
    o.y = pk4_fp8(__uint_as_float(w.z << 16) * F8_SA, __uint_as_float(w.z & 0xffff0000u) * F8_SA, __uint_as_float(w.w << 16) * F8_SA, __uint_as_float(w.w & 0xffff0000u) * F8_SA); return o; }
DI u32x2 q8x8(const u32x4& w, float sa) {
    u32x2 o; o.x = pk4_q8(__uint_as_float(w.x << 16) * sa, __uint_as_float(w.x & 0xffff0000u) * sa, __uint_as_float(w.y << 16) * sa, __uint_as_float(w.y & 0xffff0000u) * sa);
    o.y = pk4_q8(__uint_as_float(w.z << 16) * sa, __uint_as_float(w.z & 0xffff0000u) * sa, __uint_as_float(w.w << 16) * sa, __uint_as_float(w.w & 0xffff0000u) * sa); return o; }
DI void add8(u32x4& w, const f32x4& a0, const f32x4& a1, float& ss) {
    float v[8] = { __uint_as_float(w.x << 16) + a0[0], __uint_as_float(w.x & 0xffff0000u) + a0[1], __uint_as_float(w.y << 16) + a0[2], __uint_as_float(w.y & 0xffff0000u) + a0[3],
                   __uint_as_float(w.z << 16) + a1[0], __uint_as_float(w.z & 0xffff0000u) + a1[1], __uint_as_float(w.w << 16) + a1[2], __uint_as_float(w.w & 0xffff0000u) + a1[3] };
    ss += ((v[0] * v[0] + v[1] * v[1]) + (v[2] * v[2] + v[3] * v[3])) + ((v[4] * v[4] + v[5] * v[5]) + (v[6] * v[6] + v[7] * v[7]));
    w.x = cvtpk(v[0], v[1]); w.y = cvtpk(v[2], v[3]); w.z = cvtpk(v[4], v[5]); w.w = cvtpk(v[6], v[7]);
}
template <bool W8, int MODE = 0> struct EpiResid {
    static constexpr bool PERM = true, COLMAP = true;
    bf16_t* hb; u64* rowss_out; unsigned char* hb8; float ascale; const u64* rowss_q; const float* wmax; int* xacc; const bf16_t* xw; LAS int* xl;
    DI void operator()(const f32x4 (&acc)[2][2][4][2], const Unit& u, int wr, int wc, int fr, int fq) const {
        const int row0 = u.pm * BM + wr * 64 + fr, col0 = u.pn * BM + wc * 64 + 8 * fq;
        f32x4 wi[2][2] = {{{1.f, 1.f, 1.f, 1.f}, {1.f, 1.f, 1.f, 1.f}}, {{1.f, 1.f, 1.f, 1.f}, {1.f, 1.f, 1.f, 1.f}}};
        bf16x8 xa[2] = {{0, 0, 0, 0, 0, 0, 0, 0}, {0, 0, 0, 0, 0, 0, 0, 0}};
#pragma unroll
        for (int ai = 0; ai < 2; ++ai) {
        u32x4 w[4][2];
#pragma unroll
        for (int m = 0; m < 4; ++m) { const bf16_t* p = hb + (size_t)(row0 + ai * HALF + m * 16) * DM + col0; w[m][0] = *(const u32x4*)p; w[m][1] = *(const u32x4*)(p + 32); }
        u64 rq[4];
        if (W8) {
#pragma unroll
            for (int m = 0; m < 4; ++m) rq[m] = rowss_q[row0 + ai * HALF + m * 16]; }
        if (ai == 0) {
            f32x4 wr_[2][2];
            if (MODE == 2) {
#pragma unroll
                for (int bj = 0; bj < 2; ++bj) { wr_[bj][0] = *(const f32x4*)(wmax + col0 + 32 * bj); wr_[bj][1] = *(const f32x4*)(wmax + col0 + 32 * bj + 4); } }
            if (xacc && fr < 8) { xa[0] = *(const bf16x8*)(xw + (size_t)fr * DM + col0); xa[1] = *(const bf16x8*)(xw + (size_t)fr * DM + col0 + 32); }
            asm volatile("" ::: "memory");
            if (MODE == 2) {
#pragma unroll
                for (int bj = 0; bj < 2; ++bj) { wi[bj][0] = wr_[bj][0] * (ascale / 127.0f); wi[bj][1] = wr_[bj][1] * (ascale / 127.0f); } }
        }
        asm volatile("" ::: "memory");
#pragma unroll
            for (int m = 0; m < 4; ++m) {
                const int row = row0 + ai * HALF + m * 16; bf16_t* p = hb + (size_t)row * DM + col0; float ss = 0.f;
                u32x4 w0 = w[m][0], w1 = w[m][1];
                if (MODE == 2) { f32x4 t[2][2];
#pragma unroll
                    for (int bj = 0; bj < 2; ++bj)
#pragma unroll
                        for (int n = 0; n < 2; ++n)
#pragma unroll
                            for (int k = 0; k < 4; ++k) t[bj][n][k] = i2f(acc[ai][bj][m][n][k]) * wi[bj][n][k];
                    add8(w0, t[0][0], t[0][1], ss); add8(w1, t[1][0], t[1][1], ss); }
                else { add8(w0, acc[ai][0][m][0] * ascale, acc[ai][0][m][1] * ascale, ss); add8(w1, acc[ai][1][m][0] * ascale, acc[ai][1][m][1] * ascale, ss); }
                *(u32x4*)p = w0; *(u32x4*)(p + 32) = w1;
                if (xacc) { f32x4 d = {0.f, 0.f, 0.f, 0.f};
                    d = __builtin_amdgcn_mfma_f32_16x16x32_bf16(xa[0], __builtin_bit_cast(bf16x8, w0), d, 0, 0, 0); d = __builtin_amdgcn_mfma_f32_16x16x32_bf16(xa[1], __builtin_bit_cast(bf16x8, w1), d, 0, 0, 0);
                    if (fq < 2) {
#pragma unroll
                        for (int r = 0; r < 4; ++r) __hip_atomic_fetch_add(xl + (wr * 64 + fr + ai * HALF + m * 16) * 8 + 4 * fq + r, (int)__builtin_rintf(d[r] * XFIX), __ATOMIC_RELAXED, __HIP_MEMORY_SCOPE_WORKGROUP); } }
                if (W8) { const float sa = rs_from(rq[m]) * (127.0f / Q8_R); unsigned char* q = hb8 + (size_t)row * DM + col0; *(u32x2*)q = GU_MODE == 2 ? q8x8(w0, sa) : bf8x8(w0); *(u32x2*)(q + 32) = GU_MODE == 2 ? q8x8(w1, sa) : bf8x8(w1); }
                ss += __shfl_xor(ss, 16); ss += __shfl_xor(ss, 32);
                if (fq == 0) __hip_atomic_fetch_add(rowss_out + row, (u64)(ss * RS_FIX), __ATOMIC_RELAXED, __HIP_MEMORY_SCOPE_AGENT);
            }
        asm volatile("" ::: "memory");
        }
        if (xacc) {
            asm volatile("s_waitcnt lgkmcnt(0)" ::: "memory"); __builtin_amdgcn_s_barrier(); asm volatile("" ::: "memory");
            const int t = (wr * 4 + wc) * 64 + fq * 16 + fr; const i32x4 v = *(const LAS i32x4*)(xl + 4 * t);
            *(i32x4*)(xacc + (size_t)u.pn * XPLANE + (size_t)u.pm * BM * 8 + 4 * t) = v; *(LAS i32x4*)(xl + 4 * t) = (i32x4){0, 0, 0, 0};
        }
    }
};
template <bool MOE, int MODE = 1> struct EpiSwiglu {
    static constexpr bool PERM = true, COLMAP = false;
    unsigned char* act; int ldo; const u64* rowss; const int* tok; const u64* rowss_q; const float* wmax; const float* rsl = nullptr; const float* gatel = nullptr;
    DI void operator()(const f32x4 (&acc)[2][2][4][2], const Unit& u, int wr, int wc, int fr, int fq) const {
        const int r0 = wr * 64 + fr; const int col = u.pn * HALF + wc * 32 + 8 * fq;
        int srow[2][4]; u64 rsv[2][4], rqv[2][4]; float rsm[2][4], gtm[2][4];
        constexpr bool LISTED = MOE && MODE == 2;
#pragma unroll
        for (int ai = 0; ai < 2; ++ai)
#pragma unroll
            for (int m = 0; m < 4; ++m) { const int r = r0 + ai * HALF + m * 16; srow[ai][m] = u.pm * BM + r; rsm[ai][m] = 0.f; gtm[ai][m] = 1.f;
                if (MOE) { const int rr = r < u.valid ? r : 0; if (LISTED) { rsm[ai][m] = rsl[(size_t)u.c * MTOK + u.lt * 256 + rr]; gtm[ai][m] = gatel[(size_t)u.c * MTOK + u.lt * 256 + rr]; } else srow[ai][m] = tok[(size_t)u.c * MTOK + u.lt * 256 + rr]; } }
        if (!LISTED) {
#pragma unroll
        for (int ai = 0; ai < 2; ++ai)
#pragma unroll
            for (int m = 0; m < 4; ++m) { rsv[ai][m] = rowss[srow[ai][m]]; if (MODE == 2) rqv[ai][m] = rowss_q[srow[ai][m]]; } }
        f32x4 wg[2] = {{1.f, 1.f, 1.f, 1.f}, {1.f, 1.f, 1.f, 1.f}}, wu[2] = {{1.f, 1.f, 1.f, 1.f}, {1.f, 1.f, 1.f, 1.f}};
        if (MODE == 2) { const float* wm = wmax + (MOE ? (u.c & 7) * 2048 : 0) + u.pn * BM + wc * 32 + 8 * fq;
            wg[0] = *(const f32x4*)wm * (1.0f / 127.0f); wg[1] = *(const f32x4*)(wm + 4) * (1.0f / 127.0f); wu[0] = *(const f32x4*)(wm + HALF) * (1.0f / 127.0f); wu[1] = *(const f32x4*)(wm + HALF + 4) * (1.0f / 127.0f); }
#pragma unroll
        for (int ai = 0; ai < 2; ++ai)
#pragma unroll
            for (int m = 0; m < 4; ++m) {
                const int r = r0 + ai * HALF + m * 16;
                float rs;
                if (LISTED) rs = rsm[ai][m];
                else { rs = rs_from(rsv[ai][m]);
                if (MODE == 1) rs *= 1.0f / (F8_SA * F8_SW);
                if (MODE == 2) rs *= (Q8_R / 127.0f) / rs_from(rqv[ai][m]); }
                const float ru = rs * (MODE ? F8_SACT : 1.0f) * (LISTED ? gtm[ai][m] : 1.0f);
                f32x4 ga, gb, ua, ub;
                if (MODE == 2) {
#pragma unroll
                    for (int k = 0; k < 4; ++k) { ga[k] = i2f(acc[ai][0][m][0][k]) * wg[0][k]; gb[k] = i2f(acc[ai][0][m][1][k]) * wg[1][k]; ua[k] = i2f(acc[ai][1][m][0][k]) * wu[0][k]; ub[k] = i2f(acc[ai][1][m][1][k]) * wu[1][k]; }
                } else { ga = acc[ai][0][m][0]; gb = acc[ai][0][m][1]; ua = acc[ai][1][m][0]; ub = acc[ai][1][m][1]; }
                ga = ga * rs; gb = gb * rs; ua = ua * ru; ub = ub * ru;
                float o[8];
#pragma unroll
                for (int k = 0; k < 4; ++k) { o[k] = ga[k] * sigmoidf_(ga[k]) * ua[k]; o[4 + k] = gb[k] * sigmoidf_(gb[k]) * ub[k]; }
                if (MODE) { u32x2 w; w.x = pk4_fp8(o[0], o[1], o[2], o[3]); w.y = pk4_fp8(o[4], o[5], o[6], o[7]); *(u32x2*)(act + (size_t)(u.pm * BM + r) * ldo + col) = w; }
                else { u32x4 w; w.x = cvtpk(o[0], o[1]); w.y = cvtpk(o[2], o[3]); w.z = cvtpk(o[4], o[5]); w.w = cvtpk(o[6], o[7]); *(u32x4*)((bf16_t*)act + (size_t)(u.pm * BM + r) * ldo + col) = w; }
            }
    }
};
template <bool FINAL> struct EpiMoeDown {
    static constexpr bool PERM = true, COLMAP = true;
    bf16_t* hb; u64* rowss_out; const int* tok; const float* gate; float ascale; unsigned char* hb8; const u64* rowss_q; int* xacc; const bf16_t* xw; LAS int* xl;
    DI void operator()(const f32x4 (&acc)[2][2][4][2], const Unit& u, int wr, int wc, int fr, int fq) const {
        const int r0 = wr * 64 + fr, col0 = u.pn * BM + wc * 64 + 8 * fq;
        bf16x8 xa[2] = {{0, 0, 0, 0, 0, 0, 0, 0}, {0, 0, 0, 0, 0, 0, 0, 0}};
        if (FINAL && xacc && fr < 8) { xa[0] = *(const bf16x8*)(xw + (size_t)fr * DM + col0); xa[1] = *(const bf16x8*)(xw + (size_t)fr * DM + col0 + 32); }
        int rowv[2][4]; float gtv[2][4];
#pragma unroll
        for (int ai = 0; ai < 2; ++ai)
#pragma unroll
            for (int m = 0; m < 4; ++m) { const int r = r0 + ai * HALF + m * 16; const size_t li = (size_t)u.c * MTOK + u.lt * 256 + (r < u.valid ? r : 0); rowv[ai][m] = tok[li]; gtv[ai][m] = gate ? gate[li] : 1.0f; }
#pragma unroll
        for (int ai = 0; ai < 2; ++ai) {
        u32x4 w[4][2];
#pragma unroll
        for (int m = 0; m < 4; ++m) { const bf16_t* p = hb + (size_t)rowv[ai][m] * DM + col0; w[m][0] = *(const u32x4*)p; w[m][1] = *(const u32x4*)(p + 32); }
        u64 rq[4];
        if (FINAL && G1_MODE == 2) {
#pragma unroll
            for (int m = 0; m < 4; ++m) rq[m] = rowss_q[rowv[ai][m]]; }
        asm volatile("" ::: "memory");
#pragma unroll
            for (int m = 0; m < 4; ++m) {
                const int r = r0 + ai * HALF + m * 16; const int r_ = r; const bool ok = r < u.valid;
                const int row = rowv[ai][m]; const float gt = gtv[ai][m] * ascale; bf16_t* p = hb + (size_t)row * DM + col0; float ss = 0.f;
                if (ok) {
                    u32x4 w0 = w[m][0], w1 = w[m][1];
                    add8(w0, acc[ai][0][m][0] * gt, acc[ai][0][m][1] * gt, ss); add8(w1, acc[ai][1][m][0] * gt, acc[ai][1][m][1] * gt, ss);
                    *(u32x4*)p = w0; *(u32x4*)(p + 32) = w1;
                    if (FINAL && G1_MODE == 2) { const float sa = rs_from(rq[m]) * (127.0f / Q8_R); unsigned char* q = hb8 + (size_t)row * DM + col0; *(u32x2*)q = q8x8(w0, sa); *(u32x2*)(q + 32) = q8x8(w1, sa); }
                    w[m][0] = w0; w[m][1] = w1;
                }
                if (FINAL && xacc) { f32x4 d = {0.f, 0.f, 0.f, 0.f};
                    d = __builtin_amdgcn_mfma_f32_16x16x32_bf16(xa[0], __builtin_bit_cast(bf16x8, w[m][0]), d, 0, 0, 0); d = __builtin_amdgcn_mfma_f32_16x16x32_bf16(xa[1], __builtin_bit_cast(bf16x8, w[m][1]), d, 0, 0, 0);
                    if (fq < 2 && ok) {
#pragma unroll
                        for (int r = 0; r < 4; ++r) __hip_atomic_fetch_add(xl + r_ * 8 + 4 * fq + r, (int)__builtin_rintf(d[r] * XFIX), __ATOMIC_RELAXED, __HIP_MEMORY_SCOPE_WORKGROUP); } }
                if (FINAL) { ss += __shfl_xor(ss, 16); ss += __shfl_xor(ss, 32);
                    if (fq == 0 && ok) __hip_atomic_fetch_add(rowss_out + row, (u64)(ss * RS_FIX), __ATOMIC_RELAXED, __HIP_MEMORY_SCOPE_AGENT); }
            }
        asm volatile("" ::: "memory");
        }
        if (FINAL && xacc) {
            asm volatile("s_waitcnt lgkmcnt(0)" ::: "memory"); __builtin_amdgcn_s_barrier(); asm volatile("" ::: "memory");
            const int t = (wr * 4 + wc) * 64 + fq * 16 + fr; const int rl = t >> 1; const i32x4 v = *(const LAS i32x4*)(xl + 4 * t);
            if (rl < u.valid) { const int trow = tok[(size_t)u.c * MTOK + u.lt * 256 + rl]; *(i32x4*)(xacc + (size_t)u.pn * XPLANE + (size_t)trow * 8 + 4 * (t & 1)) = v; }
            *(LAS i32x4*)(xl + 4 * t) = (i32x4){0, 0, 0, 0};
        }
    }
};
}

#define XB_TMO      128
#define XB_XCNT(j)  (256  + 64 * (j))
#define XB_XSUB(j)  (1280 + 64 * (j))
#define XB_XGEN(j)  (2304 + 64 * (j))
#define XB_TOP      3328
#define XB_TOPGEN   3392
#define XCD_BAR_WORDS 3456
#define XB_SPIN_CAP (1u << 18)
DI unsigned xb_ld(unsigned* p)              { return __hip_atomic_load(p, __ATOMIC_RELAXED, __HIP_MEMORY_SCOPE_AGENT); }
DI unsigned xb_add(unsigned* p, unsigned v) { return __hip_atomic_fetch_add(p, v, __ATOMIC_RELAXED, __HIP_MEMORY_SCOPE_AGENT); }
DI unsigned xb_xcc_id() { return (unsigned)__builtin_amdgcn_s_getreg((3 << 11) | 20) & 0xFu; }
#define XB_SPIN(cond, bar) do { unsigned _sp = 0; while (cond) { __builtin_amdgcn_s_sleep(1); \
    if ((++_sp & 255u) == 0u) { if (xb_ld(&(bar)[XB_TMO])) break; if (_sp > XB_SPIN_CAP) { atomicAdd(&(bar)[XB_TMO], 1u); break; } } } } while (0)
struct XcdBarrier { unsigned* bar; unsigned x; volatile LAS unsigned* st; };
DI XcdBarrier xcd_barrier_post(unsigned* bar, volatile LAS unsigned* st) {
    XcdBarrier b; b.bar = bar; b.x = xb_xcc_id(); b.st = st;
    if (threadIdx.x == 0) (void)xb_add(&bar[XB_XCNT(b.x)], 1u);
    return b;
}
DI void xcd_barrier_complete(unsigned* bar, unsigned x, unsigned& nloc, unsigned& nx) {
    const unsigned G = gridDim.x * gridDim.y * gridDim.z;
    unsigned sum, cnt, mine, sp = 0u;
    for (;;) {
        sum = 0u; cnt = 0u; mine = 0u;
#pragma unroll
        for (unsigned j = 0; j < 16; ++j) { const unsigned c = xb_ld(&bar[XB_XCNT(j)]); sum += c; cnt += (c > 0u) ? 1u : 0u; mine = (j == x) ? c : mine; }
        if (sum == G) break;
        __builtin_amdgcn_s_sleep(1);
        if ((++sp & 255u) == 0u) { if (xb_ld(&bar[XB_TMO])) break; if (sp > XB_SPIN_CAP) { atomicAdd(&bar[XB_TMO], 1u); break; } }
    }
    nloc = mine > 0u ? mine : 1u; nx = cnt > 0u ? cnt : 1u;
}
DI void xcd_barrier(const XcdBarrier& b) {
    asm volatile("s_waitcnt vmcnt(0)" ::: "memory");
    __syncthreads();
    if (threadIdx.x == 0) {
        unsigned* bar = b.bar;
        __builtin_amdgcn_s_waitcnt(0);
        unsigned nloc = b.st[0], nx = b.st[1];
        if (nloc == 0u) { xcd_barrier_complete(bar, b.x, nloc, nx); b.st[0] = nloc; b.st[1] = nx; }
        const unsigned old = xb_add(&bar[XB_XSUB(b.x)], 1u);
        const unsigned gen = old / nloc;
        if (old + 1u == (gen + 1u) * nloc) {
            __builtin_amdgcn_fence(__ATOMIC_RELEASE, "agent");
            asm volatile("s_waitcnt vmcnt(0)" ::: "memory");
            const unsigned og = xb_add(&bar[XB_TOP], 1u);
            const unsigned tg = og / nx;
            if (og + 1u == (tg + 1u) * nx) xb_add(&bar[XB_TOPGEN], 1u);
            else XB_SPIN(xb_ld(&bar[XB_TOPGEN]) == tg, bar);
            __builtin_amdgcn_fence(__ATOMIC_ACQUIRE, "agent");
            xb_add(&bar[XB_XGEN(b.x)], 1u);
            asm volatile("s_waitcnt vmcnt(0)" ::: "memory");
        } else {
            XB_SPIN(xb_ld(&bar[XB_XGEN(b.x)]) == gen, bar);
            __builtin_amdgcn_fence(__ATOMIC_ACQUIRE, "agent");
            asm volatile("s_waitcnt vmcnt(0)" ::: "memory");
        }
    }
    __syncthreads();
}

struct Args {
    const float* x; const float* attn_norm; const float* w_in; const float* b_forget; const float* fox_q_norm; const float* fox_k_norm; const float* sb_out_norm; const float* fox_out_norm;
    const float* w_out; const float* ffn_norm; const float* dense_w_gate; const float* dense_w_up; const float* dense_w_down; const float* router_w; const float* moe_w_gate; const float* moe_w_up;
    const float* moe_w_down; const float* final_norm; float* out; unsigned char* ws; int lo, hi;
};

DI int opaque_tid() { int t = threadIdx.x; asm volatile("" : "+v"(t)); return t; }
typedef const __attribute__((address_space(4))) Args* CArgsP;
typedef const __attribute__((address_space(4))) u64* CU64P;
static_assert(sizeof(Args) == 21 * 8, "Args is 21 u64 words, no padding");
DI Args args_here() { CU64P p = (CU64P)__builtin_amdgcn_kernarg_segment_ptr(); asm volatile("" : "+s"(p)); Args a; u64* d = (u64*)&a;
#pragma unroll
    for (int i = 0; i < 20; ++i) { GAS unsigned char* g = (GAS unsigned char*)p[i]; unsigned char* f = (unsigned char*)g; d[i] = (u64)f; }
    d[20] = p[20];
    return a; }
DI void transpose_item(const float* W, int ld, int K, int k0, int n0, const float* gain, bf16_t* WT, int dst_row0, LAS float* scr, int lane) {
    { float v[32], gn[32];
#pragma unroll
    for (int i = 0; i < 32; ++i) { const int kk = 2 * i + (lane >> 5); v[i] = W[(size_t)(k0 + kk) * ld + n0 + (lane & 31)]; gn[i] = gain ? gain[k0 + kk] : 1.0f; }
#pragma unroll
    for (int i = 0; i < 32; ++i) { const int kk = 2 * i + (lane >> 5); scr[kk * 33 + (lane & 31)] = v[i] * gn[i]; } }
    asm volatile("s_waitcnt lgkmcnt(0)" ::: "memory");
    const int c = lane & 7;
#pragma unroll
    for (int j = 0; j < 4; ++j) { const int n = (lane >> 3) + 8 * j; const LAS float* s = scr + (8 * c) * 33 + n;
        u32x4 o; o.x = cvtpk(s[0 * 33], s[1 * 33]); o.y = cvtpk(s[2 * 33], s[3 * 33]); o.z = cvtpk(s[4 * 33], s[5 * 33]); o.w = cvtpk(s[6 * 33], s[7 * 33]);
        *(u32x4*)(WT + (size_t)(dst_row0 + n) * K + k0 + 8 * c) = o; }
    asm volatile("s_waitcnt lgkmcnt(0)" ::: "memory");
}
DI void transpose_item8(const float* W, int ld, int K, int k0, int n0, const float* gain, unsigned char* WT, int dst_row0, LAS float* scr, int lane) {
    { f32x4 v[8]; float gn[8];
      const int r = lane >> 3, c4 = lane & 7;
#pragma unroll
      for (int i = 0; i < 8; ++i) { const int kk = 8 * i + r; v[i] = *(const f32x4*)(W + (size_t)(k0 + kk) * ld + n0 + 4 * c4); gn[i] = gain ? gain[k0 + kk] * F8_SW : F8_SW; }
#pragma unroll
      for (int i = 0; i < 8; ++i) { const int kk = 8 * i + r;
#pragma unroll
          for (int j = 0; j < 4; ++j) scr[kk * 33 + 4 * c4 + j] = v[i][j] * gn[i]; } }
    asm volatile("s_waitcnt lgkmcnt(0)" ::: "memory");
    const int c = lane & 7;
#pragma unroll
    for (int j = 0; j < 4; ++j) { const int n = (lane >> 3) + 8 * j; const LAS float* s = scr + (8 * c) * 33 + n;
        u32x2 o; o.x = pk4_fp8(s[0 * 33], s[1 * 33], s[2 * 33], s[3 * 33]); o.y = pk4_fp8(s[4 * 33], s[5 * 33], s[6 * 33], s[7 * 33]);
        *(u32x2*)(WT + (size_t)(dst_row0 + n) * K + k0 + 8 * c) = o; }
    asm volatile("s_waitcnt lgkmcnt(0)" ::: "memory");
}
DI void transpose_item_q8(const float* W, int ld, int K, int k0, int n0, const float* gain, unsigned char* WT, int dst_row0, const float* wmax, LAS float* scr, int lane) {
    { float v[32], gn[32];
#pragma unroll
    for (int i = 0; i < 32; ++i) { const int kk = 2 * i + (lane >> 5); v[i] = W[(size_t)(k0 + kk) * ld + n0 + (lane & 31)]; gn[i] = gain ? gain[k0 + kk] : 1.0f; }
#pragma unroll
    for (int i = 0; i < 32; ++i) { const int kk = 2 * i + (lane >> 5); scr[kk * 33 + (lane & 31)] = v[i] * gn[i]; } }
    asm volatile("s_waitcnt lgkmcnt(0)" ::: "memory");
    const int c = lane & 7;
#pragma unroll
    for (int j = 0; j < 4; ++j) { const int n = (lane >> 3) + 8 * j; const LAS float* s = scr + (8 * c) * 33 + n; const float sw = 127.0f / __builtin_fmaxf(wmax[dst_row0 + n], 1e-30f);
        u32x2 o; o.x = pk4_q8(s[0 * 33] * sw, s[1 * 33] * sw, s[2 * 33] * sw, s[3 * 33] * sw); o.y = pk4_q8(s[4 * 33] * sw, s[5 * 33] * sw, s[6 * 33] * sw, s[7 * 33] * sw);
        *(u32x2*)(WT + (size_t)(dst_row0 + n) * K + k0 + 8 * c) = o; }
    asm volatile("s_waitcnt lgkmcnt(0)" ::: "memory");
}
DI void wmax_item(const float* W, int ld, int k0, int n0, const float* gain, float* wmax, int dst_row0, int lane) {
    float v[32], gn[32];
#pragma unroll
    for (int i = 0; i < 32; ++i) { const int kk = 2 * i + (lane >> 5); v[i] = W[(size_t)(k0 + kk) * ld + n0 + (lane & 31)]; gn[i] = gain ? gain[k0 + kk] : 1.0f; }
    float m = 0.f;
#pragma unroll
    for (int i = 0; i < 32; ++i) m = __builtin_fmaxf(m, __builtin_fabsf(v[i] * gn[i]));
    m = __builtin_fmaxf(m, __shfl_xor(m, 32));
    if (lane < 32) __hip_atomic_fetch_max((unsigned*)(wmax + dst_row0 + lane), __float_as_uint(m), __ATOMIC_RELAXED, __HIP_MEMORY_SCOPE_AGENT);
}
DI int dst_row_of(int mode, int n0) { return mode == 0 ? n0 : (n0 / 128) * 256 + (n0 % 128) + (mode == 2 ? 128 : 0); }
DI void convert_mat_item(const float* W, int ld, int K, int N, const float* gain, bf16_t* WT, int mode, int item, LAS float* scr, int lane) {
    const int nblk = N / 32, kb = item / nblk, nb = item % nblk, n0 = 32 * nb;
    const int dst = mode == 0 ? n0 : (n0 / 128) * 256 + (n0 % 128) + (mode == 2 ? 128 : 0);
    transpose_item(W, ld, K, 64 * kb, n0, gain, WT, dst, scr, lane);
}
DI void convert_mat_item_q8(const float* W, int ld, int K, int N, const float* gain, unsigned char* WT, int mode, int item, const float* wmax, LAS float* scr, int lane) {
    const int nblk = N / 32, kb = item / nblk, nb = item % nblk, n0 = 32 * nb;
    transpose_item_q8(W, ld, K, 64 * kb, n0, gain, WT, dst_row_of(mode, n0), wmax, scr, lane);
}
DI void wmax_mat_item(const float* W, int ld, int N, const float* gain, float* wmax, int mode, int item, int lane) {
    const int nblk = N / 32, kb = item / nblk, nb = item % nblk, n0 = 32 * nb;
    wmax_item(W, ld, 64 * kb, n0, gain, wmax, dst_row_of(mode, n0), lane);
}
DI void convert_mat_item8(const float* W, int ld, int K, int N, const float* gain, unsigned char* WT, int mode, int item, LAS float* scr, int lane) {
    const int nblk = N / 32, kb = item / nblk, nb = item % nblk, n0 = 32 * nb;
    const int dst = mode == 0 ? n0 : (n0 / 128) * 256 + (n0 % 128) + (mode == 2 ? 128 : 0);
    transpose_item8(W, ld, K, 64 * kb, n0, gain, WT, dst, scr, lane);
}
#ifndef GU_MODE
#define GU_MODE 2
#endif
DI void wmax_layer(const Args& a, int l, int gw, int NGW, int lane) {
    float* wm = (float*)(a.ws + WS_WMAX) + (size_t)l * WMAX_LAYER; const float* fn = a.ffn_norm + l * DM; const int li = l >> 1;
    if (G1_MODE == 2) { const float* w_in = a.w_in + (size_t)l * DM * P_IN; const float* an = a.attn_norm + l * DM; constexpr int I_IN = 32 * 224;
        for (int it = gw; it < I_IN; it += NGW) wmax_mat_item(w_in, P_IN, PROJ_N, an, wm + WMAX_IN, 0, it, lane); }
    if (G2_MODE == 2) { const float* w_out = a.w_out + (size_t)l * DM * DM; constexpr int I_OUT = 32 * 64;
        for (int it = gw; it < I_OUT; it += NGW) wmax_mat_item(w_out, DM, DM, nullptr, wm + WMAX_OUT, 0, it, lane); }
    if (GU_MODE != 2) return;
    if ((l & 1) == 0) {
        const float* wg = a.dense_w_gate + (size_t)li * DM * DFF; const float* wu = a.dense_w_up + (size_t)li * DM * DFF; constexpr int I_G = 32 * 176;
        for (int it = gw; it < 2 * I_G; it += NGW) { if (it < I_G) wmax_mat_item(wg, DFF, DFF, fn, wm + WMAX_GU, 1, it, lane); else wmax_mat_item(wu, DFF, DFF, fn, wm + WMAX_GU, 2, it - I_G, lane); }
    } else {
        const float* wg = a.moe_w_gate + (size_t)li * NE * DM * DFE; const float* wu = a.moe_w_up + (size_t)li * NE * DM * DFE; constexpr int I_E = 32 * 32;
        for (int it = gw; it < 2 * NE * I_E; it += NGW) { const int kind = it / (NE * I_E), e = (it / I_E) % NE, ri = it % I_E;
            wmax_mat_item((kind ? wu : wg) + (size_t)e * DM * DFE, DFE, DFE, fn, wm + WMAX_GU + e * 2048, kind ? 2 : 1, ri, lane); }
    }
}
#ifndef DENSE_F8_MASK
#define DENSE_F8_MASK 3
#endif
#define DENSE_IS_F8(l) (((DENSE_F8_MASK) >> ((l) >> 1)) & 1)
DI void convert_layer(const Args& a, int l, LAS float* scr, int gw, int NGW, int lane) {
    unsigned char* slot = a.ws + WS_WBUF + (size_t)(l & 1) * WSLOT;
    bf16_t* Win_t = (bf16_t*)(slot + WO_WIN); bf16_t* Wf_t = (bf16_t*)(slot + WO_WF); bf16_t* Wr_t = (bf16_t*)(slot + WO_WR); bf16_t* Wout_t = (bf16_t*)(slot + WO_WOUT);
    unsigned char* Wgu_t = slot + WO_FFN_GU;
    const float* w_in = a.w_in + (size_t)l * DM * P_IN; const float* w_out = a.w_out + (size_t)l * DM * DM;
    const float* an = a.attn_norm + l * DM; const float* fn = a.ffn_norm + l * DM; const int li = l >> 1;
    const float* wmx = (const float*)(a.ws + WS_WMAX) + (size_t)l * WMAX_LAYER;
    constexpr int I_IN = 32 * 224, I_OUT = 32 * 64;
    if ((l & 1) == 0) {
        unsigned char* Wd_t = slot + WO_DENSE_D;
        const float* wg = a.dense_w_gate + (size_t)li * DM * DFF; const float* wu = a.dense_w_up + (size_t)li * DM * DFF; const float* wd = a.dense_w_down + (size_t)li * DFF * DM;
        constexpr int I_G = 32 * 176, I_D = 88 * 64, NIT = I_IN + I_OUT + 2 * I_G + I_D;
        for (int it = gw; it < NIT; it += NGW) {
            int r = it;
            if (r < I_IN) { if (G1_MODE == 2) convert_mat_item_q8(w_in, P_IN, DM, PROJ_N, an, (unsigned char*)Win_t, 0, r, wmx + WMAX_IN, scr, lane); else convert_mat_item(w_in, P_IN, DM, PROJ_N, an, Win_t, 0, r, scr, lane); continue; } r -= I_IN;
            if (r < I_OUT) { if (G2_MODE == 2) convert_mat_item_q8(w_out, DM, DM, DM, nullptr, (unsigned char*)Wout_t, 0, r, wmx + WMAX_OUT, scr, lane); else convert_mat_item(w_out, DM, DM, DM, nullptr, Wout_t, 0, r, scr, lane); continue; } r -= I_OUT;
            if (DENSE_IS_F8(l)) {
            if (r < I_G) { if (GU_MODE == 2) convert_mat_item_q8(wg, DFF, DM, DFF, fn, Wgu_t, 1, r, wmx + WMAX_GU, scr, lane); else convert_mat_item8(wg, DFF, DM, DFF, fn, Wgu_t, 1, r, scr, lane); continue; } r -= I_G;
            if (r < I_G) { if (GU_MODE == 2) convert_mat_item_q8(wu, DFF, DM, DFF, fn, Wgu_t, 2, r, wmx + WMAX_GU, scr, lane); else convert_mat_item8(wu, DFF, DM, DFF, fn, Wgu_t, 2, r, scr, lane); continue; } r -= I_G;
            convert_mat_item8(wd, DM, DFF, DM, nullptr, Wd_t, 0, r, scr, lane);
            } else {
            if (r < I_G) { convert_mat_item(wg, DFF, DM, DFF, fn, (bf16_t*)Wgu_t, 1, r, scr, lane); continue; } r -= I_G;
            if (r < I_G) { convert_mat_item(wu, DFF, DM, DFF, fn, (bf16_t*)Wgu_t, 2, r, scr, lane); continue; } r -= I_G;
            convert_mat_item(wd, DM, DFF, DM, nullptr, (bf16_t*)Wd_t, 0, r, scr, lane);
            }
        }
    } else {
        unsigned char* Wd_t = slot + WO_MOE_D;
        const float* wg = a.moe_w_gate + (size_t)li * NE * DM * DFE; const float* wu = a.moe_w_up + (size_t)li * NE * DM * DFE; const float* wd = a.moe_w_down + (size_t)li * NE * DFE * DM;
        constexpr int I_E = 32 * 32, I_ED = 16 * 64, NIT = I_IN + I_OUT + 3 * NE * I_E;
        static_assert(I_E == I_ED, "expert item counts");
        for (int it = gw; it < NIT; it += NGW) {
            int r = it;
            if (r < I_IN) { if (G1_MODE == 2) convert_mat_item_q8(w_in, P_IN, DM, PROJ_N, an, (unsigned char*)Win_t, 0, r, wmx + WMAX_IN, scr, lane); else convert_mat_item(w_in, P_IN, DM, PROJ_N, an, Win_t, 0, r, scr, lane); continue; } r -= I_IN;
            if (r < I_OUT) { if (G2_MODE == 2) convert_mat_item_q8(w_out, DM, DM, DM, nullptr, (unsigned char*)Wout_t, 0, r, wmx + WMAX_OUT, scr, lane); else convert_mat_item(w_out, DM, DM, DM, nullptr, Wout_t, 0, r, scr, lane); continue; } r -= I_OUT;
            const int kind = r / (NE * I_E), e = (r / I_E) % NE, ri = r % I_E;
            if (kind == 0) { if (GU_MODE == 2) convert_mat_item_q8(wg + (size_t)e * DM * DFE, DFE, DM, DFE, fn, Wgu_t + (size_t)e * 2048 * DM, 1, ri, wmx + WMAX_GU + e * 2048, scr, lane); else convert_mat_item8(wg + (size_t)e * DM * DFE, DFE, DM, DFE, fn, Wgu_t + (size_t)e * 2048 * DM, 1, ri, scr, lane); }
            else if (kind == 1) { if (GU_MODE == 2) convert_mat_item_q8(wu + (size_t)e * DM * DFE, DFE, DM, DFE, fn, Wgu_t + (size_t)e * 2048 * DM, 2, ri, wmx + WMAX_GU + e * 2048, scr, lane); else convert_mat_item8(wu + (size_t)e * DM * DFE, DFE, DM, DFE, fn, Wgu_t + (size_t)e * 2048 * DM, 2, ri, scr, lane); }
            else convert_mat_item8(wd + (size_t)e * DFE * DM, DM, DFE, DM, nullptr, Wd_t + (size_t)e * DM * DFE, 0, ri, scr, lane);
        }
        const float* rw = a.router_w + (size_t)li * DM * NE;
        for (int e = gw * 64 + lane; e < 8 * DM; e += NGW * 64) { const int j = e / DM, k = e % DM; Wr_t[e] = (bf16_t)(cvtpk(rw[(size_t)k * NE + j] * fn[k], 0.f) & 0xffffu); }
    }
    for (int e = gw * 64 + lane; e < 8 * DM; e += NGW * 64) { const int j = e / DM, k = e % DM; Wf_t[e] = (bf16_t)(cvtpk(w_in[(size_t)k * P_IN + PROJ_N + j] * an[k], 0.f) & 0xffffu); }
}
struct Strip { const float* W; const float* gain; unsigned char* WT; float* wmax; int ld, n0, dst0; bool has_gain; };
constexpr int ST_PITCH = 1025;
DI void strip_load(const Strip& sp, int i0, int tid, f32x4 (&v0)[4], f32x4 (&v1)[4], f32x2 (&gg)[4]) {
    const int c4 = tid & 7, rg = tid >> 3; const float* wp = sp.W + (size_t)sp.n0 + 4 * c4;
#pragma unroll
    for (int i = 0; i < 4; ++i) { const int k = 2 * (64 * (i0 + i) + rg); v0[i] = *(const f32x4*)(wp + (size_t)k * sp.ld); v1[i] = *(const f32x4*)(wp + (size_t)(k + 1) * sp.ld); gg[i] = *(const f32x2*)(sp.gain + k); }
}
DI void strip_use(const Strip& sp, int i0, int tid, const f32x4 (&v0)[4], const f32x4 (&v1)[4], const f32x2 (&gg)[4], f32x4& m4, LAS unsigned* st) {
    const int c4 = tid & 7, rg = tid >> 3;
#pragma unroll
    for (int i = 0; i < 4; ++i) { const float g0 = sp.has_gain ? gg[i][0] : 1.0f, g1 = sp.has_gain ? gg[i][1] : 1.0f; const f32x4 a0 = v0[i] * g0, a1 = v1[i] * g1;
#pragma unroll
        for (int j = 0; j < 4; ++j) { m4[j] = __builtin_fmaxf(m4[j], __builtin_fmaxf(__builtin_fabsf(a0[j]), __builtin_fabsf(a1[j]))); st[(4 * c4 + j) * ST_PITCH + 64 * (i0 + i) + rg] = cvtpk(a0[j], a1[j]); } }
}
DI void strip_quant(const Strip& sp, LAS unsigned* st, LAS unsigned* cmax, int tid) {
    if (tid < 32) sp.wmax[sp.dst0 + tid] = __uint_as_float(cmax[tid]);
#pragma unroll
    for (int j = 0; j < 8; ++j) {
        const int q = tid + 512 * j; const int cr = (q & 15) | (((q >> 6) & 1) << 4), p = ((q >> 4) & 3) | ((q >> 7) << 2);
        const float sw = 127.0f / __builtin_fmaxf(__uint_as_float(cmax[cr]), 1e-30f);
        unsigned d[8];
#pragma unroll
        for (int e = 0; e < 8; ++e) d[e] = st[cr * ST_PITCH + 8 * p + e];
        u32x4 o;
        o.x = pk4_q8(__uint_as_float(d[0] << 16) * sw, __uint_as_float(d[0] & 0xffff0000u) * sw, __uint_as_float(d[1] << 16) * sw, __uint_as_float(d[1] & 0xffff0000u) * sw);
        o.y = pk4_q8(__uint_as_float(d[2] << 16) * sw, __uint_as_float(d[2] & 0xffff0000u) * sw, __uint_as_float(d[3] << 16) * sw, __uint_as_float(d[3] & 0xffff0000u) * sw);
        o.z = pk4_q8(__uint_as_float(d[4] << 16) * sw, __uint_as_float(d[4] & 0xffff0000u) * sw, __uint_as_float(d[5] << 16) * sw, __uint_as_float(d[5] & 0xffff0000u) * sw);
        o.w = pk4_q8(__uint_as_float(d[6] << 16) * sw, __uint_as_float(d[6] & 0xffff0000u) * sw, __uint_as_float(d[7] << 16) * sw, __uint_as_float(d[7] & 0xffff0000u) * sw);
        *(u32x4*)(sp.WT + (size_t)(sp.dst0 + cr) * DM + 16 * p) = o;
    }
}
DI void convert_layer_sp(const Args& a, int l, LAS unsigned char* ldsb, int wave, int lane) {
    static_assert(G1_MODE == 2 && G2_MODE == 2 && GU_MODE == 2, "single-pass copies are the int8 configuration");
    unsigned char* slot = a.ws + WS_WBUF + (size_t)(l & 1) * WSLOT;
    unsigned char* Win_t = slot + WO_WIN; bf16_t* Wf_t = (bf16_t*)(slot + WO_WF); bf16_t* Wr_t = (bf16_t*)(slot + WO_WR); unsigned char* Wout_t = slot + WO_WOUT; unsigned char* Wgu_t = slot + WO_FFN_GU;
    const float* w_in = a.w_in + (size_t)l * DM * P_IN; const float* w_out = a.w_out + (size_t)l * DM * DM;
    const float* an = a.attn_norm + l * DM; const float* fn = a.ffn_norm + l * DM; const int li = l >> 1; const bool moe = (l & 1) != 0;
    float* wmx = (float*)(a.ws + WS_WMAX) + (size_t)l * WMAX_LAYER;
    const int G = gridDim.x, wg = blockIdx.x; int tid = wave * 64 + lane;
    constexpr int NS_IN = PROJ_N / 32, NS_OUT = DM / 32, NS_G = DFF / 32, NS_E = DFE / 32;
    const int NS = NS_IN + NS_OUT + (moe ? 2 * NE * NS_E : 2 * NS_G);
    const float* wg_d = a.dense_w_gate + (size_t)li * DM * DFF; const float* wu_d = a.dense_w_up + (size_t)li * DM * DFF;
    const float* wg_m = a.moe_w_gate + (size_t)li * NE * DM * DFE; const float* wu_m = a.moe_w_up + (size_t)li * NE * DM * DFE;
    LAS unsigned* st = (LAS unsigned*)ldsb; LAS unsigned* cmax = st + 32 * ST_PITCH;
    auto decode = [&](int sidx, Strip& sp) -> bool {
        if (sidx >= NS) return false;
        int r = sidx;
        if (r < NS_IN) { sp = Strip{w_in, an, Win_t, wmx + WMAX_IN, P_IN, 32 * r, 32 * r, true}; return true; } r -= NS_IN;
        if (r < NS_OUT) { sp = Strip{w_out, an, Wout_t, wmx + WMAX_OUT, DM, 32 * r, 32 * r, false}; return true; } r -= NS_OUT;
        if (!moe) { const int kind = r / NS_G, n0 = 32 * (r % NS_G); sp = Strip{kind ? wu_d : wg_d, fn, Wgu_t, wmx + WMAX_GU, DFF, n0, dst_row_of(kind ? 2 : 1, n0), true}; }
        else { const int kind = r / (NE * NS_E), e = (r / NS_E) % NE, n0 = 32 * (r % NS_E);
               sp = Strip{(kind ? wu_m : wg_m) + (size_t)e * DM * DFE, fn, Wgu_t + (size_t)e * 2048 * DM, wmx + WMAX_GU + e * 2048, DFE, n0, dst_row_of(kind ? 2 : 1, n0), true}; }
        return true; };
    { Strip cur, nxt; int sidx = wg; bool have = decode(sidx, cur);
      f32x4 p0[4], p1[4], q0[4], q1[4]; f32x2 pg[4], qg[4];
      asm volatile("" : "+v"(tid));
      if (have) { strip_load(cur, 0, tid, p0, p1, pg); strip_load(cur, 4, tid, q0, q1, qg); }
      while (have) {
          __syncthreads();
          if (tid < 32) cmax[tid] = 0u;
          __syncthreads();
          f32x4 b0[4], b1[4]; f32x2 bg[4]; f32x4 m4 = {0.f, 0.f, 0.f, 0.f};
          strip_load(cur, 8, tid, b0, b1, bg);
          strip_use(cur, 0, tid, p0, p1, pg, m4, st);
          strip_load(cur, 12, tid, p0, p1, pg);
          strip_use(cur, 4, tid, q0, q1, qg, m4, st);
          strip_use(cur, 8, tid, b0, b1, bg, m4, st);
          strip_use(cur, 12, tid, p0, p1, pg, m4, st);
#pragma unroll
          for (int j = 0; j < 4; ++j) __hip_atomic_fetch_max(cmax + 4 * (tid & 7) + j, __float_as_uint(m4[j]), __ATOMIC_RELAXED, __HIP_MEMORY_SCOPE_WORKGROUP);
          __syncthreads();
          sidx += G; const bool hn = decode(sidx, nxt);
          if (hn) { strip_load(nxt, 0, tid, p0, p1, pg); strip_load(nxt, 4, tid, q0, q1, qg); }
          strip_quant(cur, st, cmax, tid);
          have = hn; cur = nxt;
      } }
    __syncthreads();
    LAS float* scr = (LAS float*)(ldsb + wave * 16384);
    const int I = moe ? NE * (DFE / 64) * (DM / 32) : (DFF / 64) * (DM / 32);
    const int base = NS / G, rem = NS % G, tgt = (32 * NS + I + G - 1) / G;
    const int ihi = max(0, tgt - 32 * (base + 1)), ilo = max(0, tgt - 32 * base);
    const int start = wg < rem ? wg * ihi : rem * ihi + (wg - rem) * ilo; int end = start + (wg < rem ? ihi : ilo); if (wg == G - 1) end = I; if (end > I) end = I;
    if (!moe) { const float* wd = a.dense_w_down + (size_t)li * DFF * DM; unsigned char* Wd_t = slot + WO_DENSE_D;
        for (int it = start + wave; it < end; it += 8) convert_mat_item8(wd, DM, DFF, DM, nullptr, Wd_t, 0, it, scr, lane); }
    else { const float* wd = a.moe_w_down + (size_t)li * NE * DFE * DM; unsigned char* Wd_t = slot + WO_MOE_D; constexpr int I_E = (DFE / 64) * (DM / 32);
        for (int it = start + wave; it < end; it += 8) { const int e = it / I_E, ri = it % I_E; convert_mat_item8(wd + (size_t)e * DFE * DM, DM, DFE, DM, nullptr, Wd_t + (size_t)e * DM * DFE, 0, ri, scr, lane); }
        const float* rw = a.router_w + (size_t)li * DM * NE; const int gw = wg * 8 + wave, NGW = G * 8;
        for (int e = gw * 64 + lane; e < 8 * DM; e += NGW * 64) { const int j = e / DM, k = e % DM; Wr_t[e] = (bf16_t)(cvtpk(rw[(size_t)k * NE + j] * fn[k], 0.f) & 0xffffu); } }
    { const int gw = wg * 8 + wave, NGW = G * 8;
      for (int e = gw * 64 + lane; e < 8 * DM; e += NGW * 64) { const int j = e / DM, k = e % DM; Wf_t[e] = (bf16_t)(cvtpk(w_in[(size_t)k * P_IN + PROJ_N + j] * an[k], 0.f) & 0xffffu); } }
}
DI void prologue_rows(const Args& a, int gw, int NGW, int lane) {
    bf16_t* hb = (bf16_t*)(a.ws + WS_HB); u64* rowss = (u64*)(a.ws + WS_ROWSS); unsigned char* hb8 = a.ws + WS_HB8;
    for (int row = gw; row < MTOK; row += NGW) {
        const f32x4* xr = (const f32x4*)(a.x + (size_t)row * DM) + 2 * lane; u32x4* br = (u32x4*)(hb + (size_t)row * DM) + lane; u32x2* b8 = (u32x2*)(hb8 + (size_t)row * DM) + lane;
        f32x4 v[8]; float s = 0.f;
#pragma unroll
        for (int j = 0; j < 4; ++j) { v[2 * j] = xr[128 * j]; v[2 * j + 1] = xr[128 * j + 1]; }
#pragma unroll
        for (int j = 0; j < 8; ++j) s += (v[j][0] * v[j][0] + v[j][1] * v[j][1]) + (v[j][2] * v[j][2] + v[j][3] * v[j][3]);
        s = wave_sum(s);
        const u64 sfix = (u64)(s * RS_FIX); const float sa8 = rs_from(sfix) * (127.0f / Q8_R);
#pragma unroll
        for (int j = 0; j < 4; ++j) { u32x4 w; w.x = cvtpk(v[2 * j][0], v[2 * j][1]); w.y = cvtpk(v[2 * j][2], v[2 * j][3]); w.z = cvtpk(v[2 * j + 1][0], v[2 * j + 1][1]); w.w = cvtpk(v[2 * j + 1][2], v[2 * j + 1][3]); br[64 * j] = w; if (G1_MODE == 2) b8[64 * j] = pg8::q8x8(w, sa8); }
        if (lane == 0) rowss[row] = sfix;
    }
}
DI void final_rows(const Args& a, int gw, int NGW, int lane) {
    const u64* rowss = (const u64*)(a.ws + WS_ROWSS) + (size_t)8 * MTOK; const bf16_t* hb = (const bf16_t*)(a.ws + WS_HB);
    f32x4 g[8];
#pragma unroll
    for (int j = 0; j < 4; ++j) { g[2 * j] = *((const f32x4*)a.final_norm + 2 * lane + 128 * j); g[2 * j + 1] = *((const f32x4*)a.final_norm + 2 * lane + 128 * j + 1); }
    for (int row = gw; row < MTOK; row += NGW) {
        const u32x4* br = (const u32x4*)(hb + (size_t)row * DM) + lane; f32x4* orow = (f32x4*)(a.out + (size_t)row * DM) + 2 * lane; const float rs = rs_from(rowss[row]);
#pragma unroll
        for (int j = 0; j < 4; ++j) { const u32x4 w = br[64 * j];
            f32x4 v0 = { __uint_as_float(w.x << 16), __uint_as_float(w.x & 0xffff0000u), __uint_as_float(w.y << 16), __uint_as_float(w.y & 0xffff0000u) };
            f32x4 v1 = { __uint_as_float(w.z << 16), __uint_as_float(w.z & 0xffff0000u), __uint_as_float(w.w << 16), __uint_as_float(w.w & 0xffff0000u) };
            orow[128 * j] = v0 * rs * g[2 * j]; orow[128 * j + 1] = v1 * rs * g[2 * j + 1]; }
    }
}
DI f32x4 skinny16(const bf16_t* hb, const bf16_t* Wt, int row0, int lane) {
    const int n = lane & 15, q = lane >> 4;
    const bf16_t* ap = hb + (size_t)(row0 + n) * DM + 512 * q; const bf16_t* bp = Wt + (size_t)(n & 7) * DM + 512 * q;
    f32x4 acc = {0.f, 0.f, 0.f, 0.f};
    for (int it = 0; it < 8; ++it) {
        bf16x8 av[8], bv[8];
#pragma unroll
        for (int u = 0; u < 8; ++u) { av[u] = *(const bf16x8*)(ap + it * 64 + u * 8); bv[u] = *(const bf16x8*)(bp + it * 64 + u * 8); }
#pragma unroll
        for (int u = 0; u < 8; ++u) { if (n >= 8) bv[u] = (bf16x8){0, 0, 0, 0, 0, 0, 0, 0}; acc = __builtin_amdgcn_mfma_f32_16x16x32_bf16(av[u], bv[u], acc, 0, 0, 0); }
    }
    return acc;
}
DI float nl_of(float dot, float rs, float bias) { const float x2 = (dot * rs + bias) * LOG2E; return fmaxf(-x2, 0.f) + fast_log2(1.0f + fast_exp2(-fabsf(x2))); }
DI void logf_rows(const Args& a, int l, int gw, int NGW, int lane) {
    const bf16_t* hb = (const bf16_t*)(a.ws + WS_HB); const bf16_t* Wf_t = (const bf16_t*)(a.ws + WS_WBUF + (size_t)(l & 1) * WSLOT + WO_WF);
    float* logf = (float*)(a.ws + WS_LOGF); const u64* rowss = (const u64*)(a.ws + WS_ROWSS) + (size_t)(2 * l) * MTOK;
    const int n = lane & 15, q = lane >> 4; const float bias = a.b_forget[l * 8 + (n & 7)];
    for (int grp = gw; grp < MTOK / 16; grp += NGW) {
        const f32x4 acc = skinny16(hb, Wf_t, grp * 16, lane);
        if (n < 8) {
#pragma unroll
            for (int j = 0; j < 4; ++j) { const int row = grp * 16 + 4 * q + j; logf[(size_t)row * 8 + n] = nl_of(acc[j], rs_from(rowss[row]), bias); }
        }
    }
}
DI void nl_rows(const Args& a, int l, int gw, int NGW, int lane) {
    const int* xacc = (const int*)(a.ws + WS_XACC) + (size_t)l * XSLOT; float* logf = (float*)(a.ws + WS_LOGF); const u64* rowss = (const u64*)(a.ws + WS_ROWSS) + (size_t)(2 * l) * MTOK;
    for (int e = gw * 64 + lane; e < MTOK * 8; e += NGW * 64) {
        int v[8];
#pragma unroll
        for (int p = 0; p < 8; ++p) v[p] = xacc[(size_t)p * XPLANE + e];
        const u64 rsv = rowss[e >> 3]; const float bias = a.b_forget[l * 8 + (e & 7)];
        const int sum = ((v[0] + v[1]) + (v[2] + v[3])) + ((v[4] + v[5]) + (v[6] + v[7]));
        logf[e] = nl_of((float)sum * (1.0f / XFIX), rs_from(rsv), bias);
    }
}
DI void router_rows(const Args& a, int l, LAS unsigned char* ldsb, int wave, int lane) {
    const int* racc = (const int*)(a.ws + WS_XACC) + (size_t)(4 + (l >> 1)) * XSLOT;
    const u64* rowss = (const u64*)(a.ws + WS_ROWSS) + (size_t)(2 * l + 1) * MTOK;
    unsigned* gcnt = (unsigned*)(a.ws + WS_CTL) + CW_MOECNT + (l >> 1) * 16 * 64;
    int* tokl = (int*)(a.ws + WS_TOK); float* gatel = (float*)(a.ws + WS_GATE); float* rsl = (float*)(a.ws + WS_RSL); const u64* rowss_q = (const u64*)(a.ws + WS_ROWSS) + (size_t)(2 * l) * MTOK;
    volatile LAS unsigned* lcnt = (volatile LAS unsigned*)(ldsb + LCTL_OFF) + LC_RT;
    volatile LAS unsigned* lcnt2 = (volatile LAS unsigned*)(ldsb + LCTL_OFF) + LC_RT2;
    unsigned* gcnt2 = (unsigned*)(a.ws + WS_CTL) + CW_PAIRCNT + (l >> 1) * 32 * 64; int* ptok = (int*)(a.ws + WS_PTOK); int* prefA = (int*)(a.ws + WS_PREFA); int* prefB = (int*)(a.ws + WS_PREFB);
    const int tid = wave * 64 + lane;
    for (int g0 = blockIdx.x * 8; g0 < MTOK / 16; g0 += gridDim.x * 8) {
        const int grp = g0 + wave;
        if (tid < 16) lcnt[tid] = 0u;
        if (tid < 32) lcnt2[tid] = 0u;
        __syncthreads();
        int e0 = 0, e1 = 1; float gt0 = 0.f, gt1 = 0.f, rsc = 0.f; unsigned p0 = 0u, p1 = 0u, pp = 0u; int pid = 0; const int row = grp * 16 + lane;
        const bool act = grp < MTOK / 16;
        if (act) {
            if (lane < 16) {
                float v[8]; const float rs1 = rs_from(rowss[row]); const float rsr = rs1 * (1.0f / XFIX); const int* xr = racc + (size_t)row * 8; rsc = rs1 * (Q8_R / 127.0f) / rs_from(rowss_q[row]);
                i32x4 s0 = {0, 0, 0, 0}, s1 = {0, 0, 0, 0};
#pragma unroll
                for (int p = 0; p < 8; ++p) { s0 += *(const i32x4*)(xr + p * XPLANE); s1 += *(const i32x4*)(xr + p * XPLANE + 4); }
#pragma unroll
                for (int k = 0; k < 4; ++k) { v[k] = (float)s0[k] * rsr; v[4 + k] = (float)s1[k] * rsr; }
                float b0 = v[0]; e0 = 0;
#pragma unroll
                for (int k = 1; k < 8; ++k) if (v[k] > b0) { b0 = v[k]; e0 = k; }
                float b1 = -INFINITY; e1 = 0;
#pragma unroll
                for (int k = 0; k < 8; ++k) if (k != e0 && v[k] > b1) { b1 = v[k]; e1 = k; }
                const float ex = fast_exp2((b1 - b0) * LOG2E); gt0 = fast_rcp(1.0f + ex); gt1 = ex * gt0;
                p0 = __hip_atomic_fetch_add((LAS unsigned*)&lcnt[e0], 1u, __ATOMIC_RELAXED, __HIP_MEMORY_SCOPE_WORKGROUP);
                p1 = __hip_atomic_fetch_add((LAS unsigned*)&lcnt[8 + e1], 1u, __ATOMIC_RELAXED, __HIP_MEMORY_SCOPE_WORKGROUP);
                pid = pair_id(min(e0, e1), max(e0, e1)); pp = __hip_atomic_fetch_add((LAS unsigned*)&lcnt2[pid], 1u, __ATOMIC_RELAXED, __HIP_MEMORY_SCOPE_WORKGROUP);
            }
        }
        __syncthreads();
        if (tid < 16) { const unsigned c = lcnt[tid]; lcnt[16 + tid] = c ? __hip_atomic_fetch_add(gcnt + 64 * tid, c, __ATOMIC_RELAXED, __HIP_MEMORY_SCOPE_AGENT) : 0u; }
        if (tid >= 64 && tid < 64 + NPAIR) { const int j = tid - 64; const unsigned c = lcnt2[j]; lcnt2[32 + j] = c ? __hip_atomic_fetch_add(gcnt2 + 64 * j, c, __ATOMIC_RELAXED, __HIP_MEMORY_SCOPE_AGENT) : 0u; }
        __syncthreads();
        if (act && lane < 16) {
            const unsigned q0 = lcnt[16 + e0] + p0, q1 = lcnt[16 + 8 + e1] + p1;
            tokl[(size_t)e0 * MTOK + q0] = row; gatel[(size_t)e0 * MTOK + q0] = gt0; rsl[(size_t)e0 * MTOK + q0] = rsc;
            tokl[(size_t)(8 + e1) * MTOK + q1] = row; gatel[(size_t)(8 + e1) * MTOK + q1] = gt1; rsl[(size_t)(8 + e1) * MTOK + q1] = rsc;
            { const unsigned qp = lcnt2[32 + pid] + pp; const int r0_ = e0 * MTOK + (int)q0, r1_ = (8 + e1) * MTOK + (int)q1;
              ptok[(size_t)pid * MTOK + qp] = row; prefA[(size_t)pid * MTOK + qp] = e0 < e1 ? r0_ : r1_; prefB[(size_t)pid * MTOK + qp] = e0 < e1 ? r1_ : r0_; }
        }
        __syncthreads();
    }
}
DI void moe_tables(const Args& a, int l, LAS unsigned char* ldsb, int c0, int nc) {
    LAS int* tab = (LAS int*)(ldsb + LCTL_OFF) + LC_MOE;
    const unsigned* gcnt = (const unsigned*)(a.ws + WS_CTL) + CW_MOECNT + (l >> 1) * 16 * 64;
    __syncthreads();
    if (threadIdx.x == 0) {
        int pt = 0;
        for (int c = 0; c < 16; ++c) { const int n = (int)gcnt[64 * c]; tab[c] = n; tab[33 + c] = pt; pt += (n + 255) >> 8; }
        int tp = 0;
        for (int j = 0; j < nc; ++j) { tab[16 + j] = tp; tp += (tab[c0 + j] + 255) >> 8; }
        tab[16 + nc] = tp;
    }
    __syncthreads();
}

DI void moe_tables_pair(const Args& a, int l, LAS unsigned char* ldsb) {
    moe_tables(a, l, ldsb, 0, 16);
    LAS int* tab2 = (LAS int*)(ldsb + LCTL_OFF) + LC_PAIR;
    const unsigned* gcnt2 = (const unsigned*)(a.ws + WS_CTL) + CW_PAIRCNT + (l >> 1) * 32 * 64;
    if (threadIdx.x == 0) { int tp = 0;
        for (int j = 0; j < NPAIR; ++j) { const int n = (int)gcnt2[64 * j]; tab2[j] = n; tab2[32 + j] = tp; tp += (n + 255) >> 8; }
        tab2[32 + NPAIR] = tp; }
    __syncthreads();
}

namespace att {
DI int crow(int i, int h) { return (i & 3) + 8 * (i >> 2) + 4 * h; }
DI float swap_add(float v) { auto rr = __builtin_amdgcn_permlane32_swap(__float_as_uint(v), __float_as_uint(v), false, false); return __uint_as_float(rr[0]) + __uint_as_float(rr[1]); }
DI float swap_max(float v) { auto rr = __builtin_amdgcn_permlane32_swap(__float_as_uint(v), __float_as_uint(v), false, false); return fmaxf(__uint_as_float(rr[0]), __uint_as_float(rr[1])); }
DI s16x4 vtr(const LAS unsigned char* p) { return __builtin_bit_cast(s16x4, __builtin_amdgcn_ds_read_tr16_b64_v4i16((LAS s16x4*)p)); }
DI bf16x8 pack8(const float* w) { u32x4 p; p.x = cvtpk(w[0], w[1]); p.y = cvtpk(w[2], w[3]); p.z = cvtpk(w[4], w[5]); p.w = cvtpk(w[6], w[7]); return __builtin_bit_cast(bf16x8, p); }
#define ATT_VMWAIT(n) asm volatile("s_waitcnt vmcnt(" #n ")" ::: "memory")
#define ATT_LGKMWAIT() asm volatile("s_waitcnt lgkmcnt(0)" ::: "memory")
DI void dma_offsets(unsigned (&doff)[8], int lane) {
    const int lr = lane >> 4, p = lane & 15;
#pragma unroll
    for (int i = 0; i < 8; ++i) { const int row = 4 * i + lr; doff[i] = (unsigned)(row * (PROJ_N * 2) + ((p ^ (row & 15)) << 4)); }
}
DI void dma_tile(const bf16_t* src  , LAS unsigned char* dst, const unsigned (&doff)[8]) {
#pragma unroll
    for (int i = 0; i < 8; ++i) __builtin_amdgcn_global_load_lds((const unsigned*)((const char*)src + doff[i]), (LAS unsigned*)(dst + i * 1024), 16, 0, 0);
}

template <int TYPE>
DI void wave_unit(LAS unsigned char* wl, const bf16_t* proj, bf16_t* mix, const float* ssq, const float* logf, const float* gout, int b, int head, int q0, float B2T, int lane) {
    asm volatile("" : "+v"(lane));
    const int r = lane & 31, h = lane >> 5;
    const int qcol = (TYPE ? 3072 : 0) + head * HD, kcol = (TYPE ? 4096 : 1024) + head * HD, vcol = (TYPE ? 5120 : 2048) + head * HD;
    const size_t rowg = (size_t)b * SEQ + q0 + r;
    LAS unsigned char* Kl = wl; LAS unsigned char* Vl = wl + 8192; LAS float* scr = (LAS float*)(wl + 16384);
    const bf16_t* kbase = proj + (size_t)b * SEQ * PROJ_N + kcol; const bf16_t* vbase = proj + (size_t)b * SEQ * PROJ_N + vcol;
    unsigned doff[8]; dma_offsets(doff, lane);
    dma_tile(kbase + (size_t)q0 * PROJ_N, Kl, doff);
    dma_tile(vbase + (size_t)q0 * PROJ_N, Vl, doff);
    float rkv = 0.f, nl = 0.f;
    f32x4 spk = {0.f, 0.f, 0.f, 0.f}, spq = {0.f, 0.f, 0.f, 0.f};
    if (TYPE) { const size_t krow = (size_t)b * SEQ + q0 + (lane & 31); spk = *(const f32x4*)(ssq + (krow * 16 + 8 + head) * 4); nl = logf[krow * 8 + head]; }
    bf16x8 qf[8];
    { const bf16_t* qp = proj + rowg * PROJ_N + qcol + 8 * h;
#pragma unroll
      for (int ds = 0; ds < 8; ++ds) qf[ds] = *(const bf16x8*)(qp + 16 * ds); }
    if (TYPE) spq = *(const f32x4*)(ssq + (rowg * 16 + head) * 4);
    asm volatile("" ::: "memory");
    if (TYPE) rkv = __builtin_amdgcn_rsqf(((spk[0] + spk[1]) + (spk[2] + spk[3])) * (1.0f / HD) + NORM_EPS);
    if (TYPE) {
        const f32x4 sp = spq;
        const float rq = __builtin_amdgcn_rsqf(((sp[0] + sp[1]) + (sp[2] + sp[3])) * (1.0f / HD) + NORM_EPS) * QK_SCALE2;
#pragma unroll
        for (int ds = 0; ds < 8; ++ds) { float f[8];
#pragma unroll
            for (int j = 0; j < 8; ++j) f[j] = bf2f((unsigned short)qf[ds][j]) * rq;
            qf[ds] = pack8(f); }
    }
    f32x16 O[4];
#pragma unroll
    for (int d = 0; d < 4; ++d)
#pragma unroll
        for (int i = 0; i < 16; ++i) O[d][i] = 0.f;
    float after = 0.f;
    float mrow = -INFINITY, lrow = 0.f, carry = 0.f;
    const LAS unsigned char* krow_p = Kl + r * 256; const int kx = r & 15;
    const int tq = (lane & 15) >> 2, tp = lane & 3, tblk = (lane >> 4) & 1;
    const LAS unsigned char* vrow_p = Vl + (4 * h + tq) * 256 + 8 * (tp & 1); const int vx = 4 * h + tq, vc0 = 2 * tblk + (tp >> 1);
    for (int kt = q0 >> 5; kt >= 0; --kt) {
        const int s0 = kt * 32; const bool diag = (s0 == q0);
        if (TYPE) {
            float sfx = nl;
#pragma unroll
            for (int o = 1; o < 32; o <<= 1) { const float t = __shfl_down(sfx, o); if ((lane & 31) + o < 32) sfx += t; }
            const float tot = __shfl(sfx, 0);
            if (lane < 32) { scr[lane] = carry + (sfx - nl); scr[32 + lane] = rkv; }
            carry += tot;
        }
        f32x4 sp_n = {0.f, 0.f, 0.f, 0.f}; float nl_n = 0.f;
        if (TYPE) { const size_t krow = (size_t)b * SEQ + (s0 >= 32 ? s0 - 32 : 0) + (lane & 31); sp_n = *(const f32x4*)(ssq + (krow * 16 + 8 + head) * 4); nl_n = logf[krow * 8 + head]; }
        if (TYPE) ATT_VMWAIT(10); else ATT_VMWAIT(8);
        f32x16 x;
#pragma unroll
        for (int i = 0; i < 16; ++i) x[i] = 0.f;
#pragma unroll
        for (int ds = 0; ds < 8; ++ds) { const bf16x8 kf = *(const LAS bf16x8*)(krow_p + (((2 * ds + h) ^ kx) << 4)); x = __builtin_amdgcn_mfma_f32_32x32x16_bf16(kf, qf[ds], x, 0, 0, 0); }
        ATT_LGKMWAIT();
        if (kt > 0) dma_tile(kbase + (size_t)(s0 - 32) * PROJ_N, Kl, doff);
        float w[16]; bool negl = false;
        if (TYPE == 0) {
            float sp[16];
#pragma unroll
            for (int i = 0; i < 16; ++i) { const bool valid = !diag || (crow(i, h) < r); const float xi = x[i];
                const float s2 = fmaxf(xi, 0.f) + fast_log2(1.0f + fast_exp2(-fabsf(xi))); sp[i] = valid ? s2 : 0.f; }
            float U = after;
#pragma unroll
            for (int g = 3; g >= 0; --g) {
                const float s3 = sp[4 * g + 3], s2 = sp[4 * g + 2] + s3, s1 = sp[4 * g + 1] + s2, s0v = sp[4 * g] + s1;
                const float T = swap_add(s0v);
                const float base = U + (h == 0 ? T - s0v : 0.f);
                const float sv[4] = {s0v, s1, s2, s3};
#pragma unroll
                for (int k = 0; k < 4; ++k) { const int i = 4 * g + k; const bool valid = !diag || (crow(i, h) < r); w[i] = valid ? fast_exp2(x[i] - (base + sv[k])) : 0.f; }
                U += T;
            }
            after = U;
        } else {
            f32x4 d2v[4], rk4[4];
#pragma unroll
            for (int g = 0; g < 4; ++g) { d2v[g] = *(const LAS f32x4*)(scr + 8 * g + 4 * h); rk4[g] = *(const LAS f32x4*)(scr + 32 + 8 * g + 4 * h); }
            float tmax = -INFINITY;
#pragma unroll
            for (int i = 0; i < 16; ++i) { const bool valid = !diag || (crow(i, h) <= r); float lgt = x[i] * rk4[i >> 2][i & 3] - d2v[i >> 2][i & 3]; lgt = valid ? lgt : -INFINITY; w[i] = lgt; tmax = fmaxf(tmax, lgt); }
            tmax = swap_max(tmax);
            negl = __all(tmax < mrow - 30.0f);
            if (!negl) {
            const float mnew = fmaxf(mrow, tmax); const float alpha = fast_exp2(mrow - mnew); mrow = mnew;
            float ps = 0.f;
#pragma unroll
            for (int i = 0; i < 16; ++i) { w[i] = fast_exp2(w[i] - mnew); ps += w[i]; }
            lrow = lrow * alpha + ps;
            if (!__all(alpha == 1.0f)) {
#pragma unroll
                for (int d = 0; d < 4; ++d)
#pragma unroll
                    for (int i = 0; i < 16; ++i) O[d][i] *= alpha;
            }
            }
        }
        const bf16x8 pf0 = pack8(w), pf1 = pack8(w + 8);
        if (kt > 0) ATT_VMWAIT(8); else ATT_VMWAIT(0);
        if (!negl) {
#pragma unroll
        for (int db = 0; db < 4; ++db) {
            const int cc = 4 * db + vc0;
            const s16x4 a0 = vtr(vrow_p + ((cc ^ vx) << 4)), a1 = vtr(vrow_p + 8 * 256 + ((cc ^ vx ^ 8) << 4)), c0 = vtr(vrow_p + 16 * 256 + ((cc ^ vx) << 4)), c1 = vtr(vrow_p + 24 * 256 + ((cc ^ vx ^ 8) << 4));
            const bf16x8 v0 = __builtin_shufflevector(a0, a1, 0, 1, 2, 3, 4, 5, 6, 7), v1 = __builtin_shufflevector(c0, c1, 0, 1, 2, 3, 4, 5, 6, 7);
            O[db] = __builtin_amdgcn_mfma_f32_32x32x16_bf16(v0, pf0, O[db], 0, 0, 0);
            O[db] = __builtin_amdgcn_mfma_f32_32x32x16_bf16(v1, pf1, O[db], 0, 0, 0);
        }
        }
        if (TYPE) { asm volatile("" : "+v"(nl_n), "+v"(sp_n));
            rkv = __builtin_amdgcn_rsqf(((sp_n[0] + sp_n[1]) + (sp_n[2] + sp_n[3])) * (1.0f / HD) + NORM_EPS); nl = nl_n; }
        if (TYPE == 0) { if (__all(after >= SB_EXIT2)) break; }
        else { if (__all(mrow + carry >= B2T)) break; }
        if (kt > 0) { ATT_LGKMWAIT(); dma_tile(vbase + (size_t)(s0 - 32) * PROJ_N, Vl, doff); }
    }
    f32x4 gnv[4][4];
#pragma unroll
    for (int d = 0; d < 4; ++d)
#pragma unroll
        for (int g = 0; g < 4; ++g) gnv[d][g] = *(const f32x4*)(gout + head * HD + 32 * d + 8 * g + 4 * h);
    u32x4 gtv[8];
    if (TYPE) { const int lr = lane >> 4, p = lane & 15; const bf16_t* gp = proj + ((size_t)b * SEQ + q0) * PROJ_N + 6144 + head * HD;
#pragma unroll
        for (int i = 0; i < 8; ++i) { const int row = 4 * i + lr; const int c = p ^ (row & 15); gtv[i] = *(const u32x4*)(gp + (size_t)row * PROJ_N + c * 8); } }
    asm volatile("" ::: "memory");
    float scale = 1.0f;
    if (TYPE) scale = fast_rcp(swap_add(lrow));
    float ss = 0.f;
#pragma unroll
    for (int d = 0; d < 4; ++d)
#pragma unroll
        for (int i = 0; i < 16; ++i) { O[d][i] *= scale; ss += O[d][i] * O[d][i]; }
    ss = swap_add(ss);
    const float rinv = __builtin_amdgcn_rsqf(ss * (1.0f / HD) + NORM_EPS);
    ATT_LGKMWAIT();
#pragma unroll
    for (int d = 0; d < 4; ++d)
#pragma unroll
        for (int g = 0; g < 4; ++g) {
            const f32x4 gn = gnv[d][g];
            u32x2 o; o.x = cvtpk(O[d][4 * g] * rinv * gn[0], O[d][4 * g + 1] * rinv * gn[1]); o.y = cvtpk(O[d][4 * g + 2] * rinv * gn[2], O[d][4 * g + 3] * rinv * gn[3]);
            *(LAS u32x2*)(Vl + r * 256 + (((4 * d + g) ^ (r & 15)) << 4) + 8 * h) = o;
        }
    ATT_LGKMWAIT();
    { const int lr = lane >> 4, p = lane & 15;
      bf16_t* op = mix + ((size_t)b * SEQ + q0) * DM + (TYPE ? 1024 : 0) + head * HD;
#pragma unroll
      for (int i = 0; i < 8; ++i) { const int row = 4 * i + lr; const int c = p ^ (row & 15);
          u32x4 y = *(const LAS u32x4*)(Vl + row * 256 + p * 16);
          if (TYPE) { const u32x4 gt = gtv[i];
              y.x = cvtpk(__uint_as_float(y.x << 16) * __uint_as_float(gt.x << 16), __uint_as_float(y.x & 0xffff0000u) * __uint_as_float(gt.x & 0xffff0000u));
              y.y = cvtpk(__uint_as_float(y.y << 16) * __uint_as_float(gt.y << 16), __uint_as_float(y.y & 0xffff0000u) * __uint_as_float(gt.y & 0xffff0000u));
              y.z = cvtpk(__uint_as_float(y.z << 16) * __uint_as_float(gt.z << 16), __uint_as_float(y.z & 0xffff0000u) * __uint_as_float(gt.z & 0xffff0000u));
              y.w = cvtpk(__uint_as_float(y.w << 16) * __uint_as_float(gt.w << 16), __uint_as_float(y.w & 0xffff0000u) * __uint_as_float(gt.w & 0xffff0000u)); }
          if (G2_MODE == 2) *(u32x2*)((unsigned char*)mix + ((size_t)b * SEQ + q0 + row) * DM + (TYPE ? 1024 : 0) + head * HD + c * 8) = pg8::q8x8(y, 127.0f / MIX_R);
          else *(u32x4*)(op + (size_t)row * DM + c * 8) = y; }
    }
    ATT_LGKMWAIT();
}
#undef ATT_VMWAIT
#undef ATT_LGKMWAIT
}

DI void attention_phase(const Args& a, int l, LAS unsigned char* ldsb, int wave, int lane) {
    const bf16_t* proj = (const bf16_t*)(a.ws + WS_PROJ); bf16_t* mix = (bf16_t*)(a.ws + WS_MIX);
    const float* ssq = (const float*)(a.ws + WS_SSQ); const float* logf = (const float*)(a.ws + WS_LOGF);
    float gqm = fmaxf(fabsf(a.fox_q_norm[l * HD + lane]), fabsf(a.fox_q_norm[l * HD + 64 + lane])), gkm = fmaxf(fabsf(a.fox_k_norm[l * HD + lane]), fabsf(a.fox_k_norm[l * HD + 64 + lane]));
    gqm = wave_max(gqm); gkm = wave_max(gkm);
    const float B2T = 1.02f * 128.0f * QK_SCALE2 * gqm * gkm + FOX_EXIT2;
    LAS unsigned char* wl = ldsb + wave * ATT_WAVE_BYTES;
    const int G = gridDim.x;
    for (int i = 0;; ++i) {
        const int Uc = i * G + blockIdx.x; if (Uc >= 2048) break;
        const int type = (Uc + i) & 1, idx = Uc >> 1, head = (idx + i) & 7, b = (idx >> 3) & 1, qb = idx >> 4;
        const int q0 = qb * 256 + wave * 32;
        if (type == 0) att::wave_unit<0>(wl, proj, mix, ssq, logf, a.sb_out_norm + l * 1024, b, head, q0, B2T, lane);
        else att::wave_unit<1>(wl, proj, mix, ssq, logf, a.fox_out_norm + l * 1024, b, head, q0, B2T, lane);
    }
}

#ifndef PH_MASK
#define PH_MASK 0xFFFF
#endif
#define PH(k) ((PH_MASK >> (k)) & 1)
#ifndef REP_MASK
#define REP_MASK 0
#endif
#define NREP(k) (((REP_MASK >> (k)) & 1) ? 2 : 1)
#define MARK(k) ([]() { asm volatile("; PHASE_MARK " #k); return true; }())
constexpr int NSTEP = 35;
__global__ void __launch_bounds__(512, 2) fwd(Args a_unused) {
    extern __shared__ __attribute__((aligned(16))) unsigned char lds_raw[];
    LAS unsigned char* ldsb = (LAS unsigned char*)lds_raw;
    const int tid0 = threadIdx.x;
    volatile LAS unsigned* lctl = (volatile LAS unsigned*)(ldsb + LCTL_OFF);
    for (int u = tid0; u < (LDS_BYTES - LCTL_OFF) / 4; u += 512) lctl[u] = 0u;
    __syncthreads();
    int lo, hi; XcdBarrier bar;
    { const Args a = args_here(); lo = a.lo; hi = a.hi; unsigned* ctl = (unsigned*)(a.ws + WS_CTL);
      bar.bar = ctl + CW_BAR; bar.x = 0; bar.st = lctl + LC_BAR;
      if (hi - lo > 1) bar = xcd_barrier_post(ctl + CW_BAR, lctl + LC_BAR); }
#define IN(k) (lo <= (k) && (k) < hi)
#define SEAM(k) do { if ((k) + 1 < hi) xcd_barrier(bar); } while (0)
#define PHASE_VARS const Args a = args_here(); const int tid = opaque_tid(), lane = tid & 63, wave = __builtin_amdgcn_readfirstlane(tid >> 6); (void)lane; const int G = gridDim.x, gw = blockIdx.x * 8 + wave, NGW = G * 8; unsigned char* ws = a.ws; float* h = a.out; bf16_t* hb = (bf16_t*)(ws + WS_HB); \
    bf16_t* proj = (bf16_t*)(ws + WS_PROJ); bf16_t* mix = (bf16_t*)(ws + WS_MIX); u64* rowss = (u64*)(ws + WS_ROWSS); (void)G; (void)gw; (void)NGW; (void)h; (void)hb; (void)proj; (void)mix; (void)rowss;

    if (PH(0) && MARK(0) && IN(1)) {
        PHASE_VARS
_Pragma("nounroll") for (int rep = 0; rep < NREP(0); ++rep) {
        convert_layer_sp(a, 0, ldsb, wave, lane); __syncthreads();
        prologue_rows(a, gw, NGW, lane); }
        SEAM(1);
    }
    for (int l = 0; l < NLAYER; ++l) {
        const int sb = 2 + 8 * l;
        if (PH(1) && MARK(1) && IN(sb)) {
            PHASE_VARS
            unsigned char* slot = ws + WS_WBUF + (size_t)(l & 1) * WSLOT;
            if (l == 0) logf_rows(a, 0, gw, NGW, lane); else nl_rows(a, l, gw, NGW, lane);
            pg8::DenseSched S{G1_MODE == 2 ? (const char*)(ws + WS_HB8) : (const char*)hb, (const char*)(slot + WO_WIN), MTOK / 256, PROJ_N / 256, G, (int)blockIdx.x, (size_t)256 * DM * (G1_MODE == 2 ? 1 : 2)};
            pg8::EpiProj<G1_MODE> E{proj, rowss + (size_t)(2 * l) * MTOK, (float*)(ws + WS_SSQ), a.fox_q_norm + l * HD, a.fox_k_norm + l * HD,
                                    rowss + (size_t)(l == 0 ? 0 : 2 * l - 1) * MTOK, (const float*)(ws + WS_WMAX) + (size_t)l * WMAX_LAYER + WMAX_IN};
            __syncthreads();
_Pragma("nounroll") for (int rep = 0; rep < NREP(1); ++rep) pg8::gemm_phase<pg8::EpiProj<G1_MODE>, pg8::DenseSched, G1_MODE>(ldsb, DM * (G1_MODE == 2 ? 1 : 2), S, E);
            SEAM(sb);
        }
        if (PH(2) && MARK(2) && IN(sb + 1)) {
            if (l + 1 < NLAYER) { PHASE_VARS convert_layer_sp(a, l + 1, ldsb, wave, lane); __syncthreads(); }
_Pragma("nounroll") for (int rep = 0; rep < NREP(2); ++rep) { PHASE_VARS attention_phase(a, l, ldsb, wave, lane); }
            SEAM(sb + 1);
        }
        if (PH(3) && MARK(3) && IN(sb + 2)) {
            PHASE_VARS
            unsigned char* slot = ws + WS_WBUF + (size_t)(l & 1) * WSLOT;
            pg8::DenseSched S{(const char*)mix, (const char*)(slot + WO_WOUT), MTOK / 256, DM / 256, G, (int)blockIdx.x, (size_t)256 * DM * (G2_MODE == 2 ? 1 : 2)};
            pg8::EpiResid<true, G2_MODE> E{hb, rowss + (size_t)(2 * l + 1) * MTOK, ws + WS_HB8, G2_MODE == 2 ? MIX_R / 127.0f : 1.0f, rowss + (size_t)(2 * l) * MTOK, (const float*)(ws + WS_WMAX) + (size_t)l * WMAX_LAYER + WMAX_OUT,
                                              (l & 1) ? (int*)(ws + WS_XACC) + (size_t)(4 + (l >> 1)) * XSLOT : nullptr, (const bf16_t*)(slot + WO_WR), (LAS int*)(ldsb + XLDS_OFF)};
            { LAS int* xz = (LAS int*)(ldsb + XLDS_OFF); for (int i = tid; i < 2048; i += 512) xz[i] = 0; __syncthreads(); }
            pg8::gemm_phase<pg8::EpiResid<true, G2_MODE>, pg8::DenseSched, G2_MODE>(ldsb, DM * (G2_MODE == 2 ? 1 : 2), S, E);
            SEAM(sb + 2);
        }
        if ((l & 1) == 0) {
            if (PH(4) && MARK(4) && IN(sb + 3)) {
                PHASE_VARS
                unsigned char* slot = ws + WS_WBUF + (size_t)(l & 1) * WSLOT;
                if (DENSE_IS_F8(l)) {
                pg8::DenseSched S{(const char*)(ws + WS_HB8), (const char*)(slot + WO_FFN_GU), MTOK / 256, 2 * DFF / 256, G, (int)blockIdx.x, (size_t)256 * DM};
                pg8::EpiSwiglu<false, GU_MODE> E{(unsigned char*)proj, DFF, rowss + (size_t)(2 * l + 1) * MTOK, nullptr, rowss + (size_t)(2 * l) * MTOK, (const float*)(ws + WS_WMAX) + (size_t)l * WMAX_LAYER + WMAX_GU};
_Pragma("nounroll") for (int rep = 0; rep < NREP(4); ++rep) pg8::gemm_phase<pg8::EpiSwiglu<false, GU_MODE>, pg8::DenseSched, GU_MODE>(ldsb, DM, S, E);
                } else {
                pg8::DenseSched S{(const char*)hb, (const char*)(slot + WO_FFN_GU), MTOK / 256, 2 * DFF / 256, G, (int)blockIdx.x, (size_t)256 * DM * 2};
                pg8::EpiSwiglu<false, 0> E{(unsigned char*)proj, DFF, rowss + (size_t)(2 * l + 1) * MTOK, nullptr, nullptr, nullptr};
_Pragma("nounroll") for (int rep = 0; rep < NREP(4); ++rep) pg8::gemm_phase<pg8::EpiSwiglu<false, 0>, pg8::DenseSched, 0>(ldsb, DM * 2, S, E);
                }
                SEAM(sb + 3);
            }
            if (PH(5) && MARK(5) && IN(sb + 4)) {
                PHASE_VARS
                unsigned char* slot = ws + WS_WBUF + (size_t)(l & 1) * WSLOT;
                if (DENSE_IS_F8(l)) {
                pg8::DenseSched S{(const char*)proj, (const char*)(slot + WO_DENSE_D), MTOK / 256, DM / 256, G, (int)blockIdx.x, (size_t)256 * DFF};
                pg8::EpiResid<(G1_MODE == 2)> E{hb, rowss + (size_t)(2 * l + 2) * MTOK, ws + WS_HB8, 1.0f / (F8_SACT * F8_SW), rowss + (size_t)(2 * l + 1) * MTOK, nullptr,
                                                  (int*)(ws + WS_XACC) + (size_t)(l + 1) * XSLOT, (const bf16_t*)(ws + WS_WBUF + (size_t)((l + 1) & 1) * WSLOT + WO_WF), (LAS int*)(ldsb + XLDS_OFF)};
                { LAS int* xz = (LAS int*)(ldsb + XLDS_OFF); for (int i = tid; i < 2048; i += 512) xz[i] = 0; __syncthreads(); }
                pg8::gemm_phase<pg8::EpiResid<(G1_MODE == 2)>, pg8::DenseSched, 1>(ldsb, DFF, S, E);
                } else {
                pg8::DenseSched S{(const char*)proj, (const char*)(slot + WO_DENSE_D), MTOK / 256, DM / 256, G, (int)blockIdx.x, (size_t)256 * DFF * 2};
                pg8::EpiResid<false> E{hb, rowss + (size_t)(2 * l + 2) * MTOK, nullptr, 1.0f, nullptr, nullptr, nullptr, nullptr, nullptr};
                pg8::gemm_phase<pg8::EpiResid<false>, pg8::DenseSched, 0>(ldsb, DFF * 2, S, E);
                }
                SEAM(sb + 4);
            }
        } else {
            const LAS int* tab = (const LAS int*)(ldsb + LCTL_OFF) + LC_MOE;
            if (PH(6) && MARK(6) && IN(sb + 3)) { PHASE_VARS router_rows(a, l, ldsb, wave, lane); SEAM(sb + 3); }
            if (PH(7) && MARK(7) && IN(sb + 4)) {
                PHASE_VARS
                unsigned char* slot = ws + WS_WBUF + (size_t)(l & 1) * WSLOT; const int* tokl = (const int*)(ws + WS_TOK);
                moe_tables(a, l, ldsb, 0, 16);
                pg8::MoeSched<true> S{(const char*)(ws + WS_HB8), (const char*)(slot + WO_FFN_GU), tab, tokl, 0, 16, G, (int)blockIdx.x, (size_t)256 * DM, (size_t)256 * DM, (size_t)2048 * DM, (unsigned)DM};
                pg8::EpiSwiglu<true, GU_MODE> E{(unsigned char*)proj, DFE, rowss + (size_t)(2 * l + 1) * MTOK, tokl, rowss + (size_t)(2 * l) * MTOK, (const float*)(ws + WS_WMAX) + (size_t)l * WMAX_LAYER + WMAX_GU, (const float*)(ws + WS_RSL), (const float*)(ws + WS_GATE)};
_Pragma("nounroll") for (int rep = 0; rep < NREP(7); ++rep) pg8::gemm_phase<pg8::EpiSwiglu<true, GU_MODE>, pg8::MoeSched<true>, GU_MODE>(ldsb, DM, S, E);
                SEAM(sb + 4);
            }
            if (PH(8) && MARK(8) && IN(sb + 5)) {
                PHASE_VARS
                unsigned char* slot = ws + WS_WBUF + (size_t)(l & 1) * WSLOT;
                moe_tables_pair(a, l, ldsb);
                pg8::PairSched S{(const char*)proj, (const char*)(slot + WO_MOE_D), tab, (const LAS int*)(ldsb + LCTL_OFF) + LC_PAIR, (const int*)(ws + WS_PREFA), (const int*)(ws + WS_PREFB), G, (int)blockIdx.x, (size_t)256 * DFE, (size_t)DM * DFE, (unsigned)DFE};
                pg8::EpiMoeDown<true> E{hb, rowss + (size_t)(2 * l + 2) * MTOK, (const int*)(ws + WS_PTOK), nullptr, 1.0f / (F8_SACT * F8_SW), ws + WS_HB8, rowss + (size_t)(2 * l + 1) * MTOK,
                                         l + 1 < NLAYER ? (int*)(ws + WS_XACC) + (size_t)(l + 1) * XSLOT : nullptr, (const bf16_t*)(ws + WS_WBUF + (size_t)((l + 1) & 1) * WSLOT + WO_WF), (LAS int*)(ldsb + XLDS_OFF)};
                { LAS int* xz = (LAS int*)(ldsb + XLDS_OFF); for (int i = tid; i < 2048; i += 512) xz[i] = 0; __syncthreads(); }
                pg8::gemm_phase<pg8::EpiMoeDown<true>, pg8::PairSched, 1>(ldsb, DFE, S, E);
                SEAM(sb + 5);
            }
        }
    }
    if (PH(10) && MARK(10) && IN(NSTEP - 1)) { PHASE_VARS final_rows(a, gw, NGW, lane); }
#undef IN
#undef SEAM
#undef PHASE_VARS
}

#ifndef MK_ONE_LAUNCH
#define MK_ONE_LAUNCH 1
#endif
extern "C" void kernel_launch(void* const* d_in, const int* in_sizes, int n_in, void* d_out, int out_size, void* d_ws, size_t ws_size, hipStream_t stream) {
    static int grid = 0;
    if (grid == 0) {
        if (n_in != 18 || in_sizes[0] != MTOK * DM || out_size != MTOK * DM || ws_size < WS_END) { fprintf(stderr, "kernel_launch: shape/workspace mismatch (n_in %d, ws %zu, need %zu); nothing launched\n", n_in, ws_size, (size_t)WS_END); grid = -1; return; }
        int dev = 0, cus = 0, per_cu = 0;
        if (hipGetDevice(&dev) != hipSuccess || hipDeviceGetAttribute(&cus, hipDeviceAttributeMultiprocessorCount, dev) != hipSuccess) { grid = -1; return; }
        if (hipFuncSetAttribute((const void*)fwd, hipFuncAttributeMaxDynamicSharedMemorySize, LDS_BYTES) != hipSuccess) { fprintf(stderr, "kernel_launch: hipFuncSetAttribute failed\n"); grid = -1; return; }
        if (hipOccupancyMaxActiveBlocksPerMultiprocessor(&per_cu, (const void*)fwd, 512, LDS_BYTES) != hipSuccess || per_cu < 1) { fprintf(stderr, "kernel_launch: occupancy query says %d\n", per_cu); }
        (void)hipGetLastError();
        grid = cus;
    }
    if (grid < 0) return;
    if (hipMemsetAsync((char*)d_ws + WS_CTL, 0, CTL_ZERO_BYTES, stream) != hipSuccess) { fprintf(stderr, "kernel_launch: memset failed\n"); return; }
    Args a{};
    a.x = (const float*)d_in[0]; a.attn_norm = (const float*)d_in[1]; a.w_in = (const float*)d_in[2]; a.b_forget = (const float*)d_in[3]; a.fox_q_norm = (const float*)d_in[4];
    a.fox_k_norm = (const float*)d_in[5]; a.sb_out_norm = (const float*)d_in[6]; a.fox_out_norm = (const float*)d_in[7]; a.w_out = (const float*)d_in[8]; a.ffn_norm = (const float*)d_in[9];
    a.dense_w_gate = (const float*)d_in[10]; a.dense_w_up = (const float*)d_in[11]; a.dense_w_down = (const float*)d_in[12]; a.router_w = (const float*)d_in[13]; a.moe_w_gate = (const float*)d_in[14];
    a.moe_w_up = (const float*)d_in[15]; a.moe_w_down = (const float*)d_in[16]; a.final_norm = (const float*)d_in[17]; a.out = (float*)d_out; a.ws = (unsigned char*)d_ws;
#if MK_ONE_LAUNCH
    a.lo = 0; a.hi = NSTEP;
    hipLaunchKernelGGL(fwd, dim3(grid), dim3(512), LDS_BYTES, stream, a);
#else
    for (int s = 0; s < NSTEP; ++s) {
        const int l = (s - 2) / 8, o = (s - 2) % 8;
        if (s >= 2 && s < NSTEP - 1) { if ((l & 1) == 0 && o >= 5) continue; if ((l & 1) == 1 && o >= 7) continue; }
        a.lo = s; a.hi = s + 1;
        hipLaunchKernelGGL(fwd, dim3(grid), dim3(512), LDS_BYTES, stream, a);
    }
#endif
    const hipError_t le = hipPeekAtLastError();
    if (le != hipSuccess) fprintf(stderr, "kernel_launch: launch failed: %s\n", hipGetErrorName(le));
}
```

```cpp
#include <hip/hip_runtime.h>
#include <cstdio>
#include <cstdint>

#ifndef GU_MODE
#define GU_MODE 2
#endif
#ifndef G2_MODE
#define G2_MODE 2
#endif
#ifndef G1_MODE
#define G1_MODE 2
#endif
#define DI __device__ __forceinline__
#define LAS __attribute__((address_space(3)))
#define GAS __attribute__((address_space(1)))

typedef unsigned short bf16_t;
typedef short bf16x8 __attribute__((ext_vector_type(8)));
typedef short s16x4 __attribute__((ext_vector_type(4)));
typedef float f32x4 __attribute__((ext_vector_type(4)));
typedef float f32x2 __attribute__((ext_vector_type(2)));
typedef float f32x16 __attribute__((ext_vector_type(16)));
typedef unsigned u32x4 __attribute__((ext_vector_type(4)));
typedef unsigned u32x2 __attribute__((ext_vector_type(2)));
typedef __bf16 bf16x2_t __attribute__((ext_vector_type(2)));
typedef unsigned long long u64;
typedef int i32x8 __attribute__((ext_vector_type(8)));
typedef int i32x4 __attribute__((ext_vector_type(4)));

constexpr int DM = 2048, NBATCH = 2, SEQ = 16384, MTOK = NBATCH * SEQ, NLAYER = 4, HD = 128;
constexpr int PROJ_N = 7168, P_IN = 7176, DFF = 5632, NE = 8, DFE = 1024;
constexpr float NORM_EPS = 1e-6f;
constexpr float LOG2E = 1.4426950408889634f;
constexpr float QK_SCALE2 = 0.08838834764831845f * 1.4426950408889634f;
constexpr float RS_FIX = 16777216.0f;
constexpr float RS_INV = 1.0f / (16777216.0f * 2048.0f);
constexpr float F8_SA = 8.0f, F8_SW = 1024.0f, F8_SACT = 16.0f;
constexpr float MIX_R = 4.0f;
constexpr float Q8_R = 5.0f;
constexpr float SB_EXIT2 = 24.0f;
constexpr float FOX_EXIT2 = 38.0f;

constexpr size_t MiB = 1u << 20;
constexpr size_t WS_CTL = 0, CTL_ZERO_BYTES = 4 * MiB;
constexpr int CW_TMO = 0;
constexpr int CW_BAR = 4096;
constexpr int CW_PAIRCNT = 20480;
constexpr int CW_MOECNT = 16384;
constexpr size_t WS_ROWSS = 1 * MiB;
constexpr size_t WS_WMAX = 3 * MiB + 512 * 1024;
constexpr int WMAX_IN = 0, WMAX_GU = 8192, WMAX_OUT = 24576, WMAX_LAYER = 32768;
constexpr size_t WS_HB = 4 * MiB;
constexpr size_t WS_PROJ = WS_HB + 128 * MiB;
constexpr size_t WS_MIX = WS_PROJ + 448 * MiB;
constexpr size_t WS_WBUF = WS_MIX + 128 * MiB;
constexpr size_t WSLOT = 134 * MiB;
constexpr size_t WO_WIN = 0, WO_WF = 28 * MiB, WO_WR = 28 * MiB + 65536, WO_WOUT = 29 * MiB, WO_FFN_GU = 37 * MiB, WO_DENSE_D = 81 * MiB, WO_MOE_D = 101 * MiB;
constexpr size_t WS_LOGF = WS_WBUF + 2 * WSLOT;
constexpr size_t WS_SSQ = WS_LOGF + 1 * MiB;
constexpr size_t WS_TOK = WS_SSQ + 8 * MiB;
constexpr size_t WS_GATE = WS_TOK + 2 * MiB;
constexpr size_t WS_HB8 = WS_GATE + 2 * MiB;
constexpr size_t WS_XACC = WS_HB8 + 64 * MiB;
constexpr size_t XPLANE = (size_t)MTOK * 8, XSLOT = 8 * XPLANE;
constexpr float XFIX = 262144.0f;
constexpr size_t WS_RSL = WS_XACC + 6 * XSLOT * 4;
constexpr size_t WS_PTOK = WS_RSL + 2 * MiB;
constexpr size_t WS_PREFA = WS_PTOK + 4 * MiB, WS_PREFB = WS_PREFA + 4 * MiB;
constexpr size_t WS_END = WS_PREFB + 4 * MiB;

constexpr int ACT_MOE_ROWS = 2 * MTOK + 16 * 256;

constexpr int RING_BYTES = 131072;
constexpr int ATT_WAVE_BYTES = 8192 + 8192 + 256;
constexpr int SCRATCH_BYTES = 145408;
constexpr int LCTL_OFF = SCRATCH_BYTES;
constexpr int LDS_BYTES = 147456;
constexpr int XLDS_OFF = RING_BYTES;
static_assert(LCTL_OFF + 1024 <= LDS_BYTES, "LDS map");
constexpr int LC_BAR = 0;
constexpr int LC_MOE = 16;
constexpr int LC_RT = 96;
constexpr int LC_PAIR = 160;
constexpr int LC_RT2 = 240;
constexpr int NPAIR = 28;
DI int pair_id(int a, int b) { return a * (15 - a) / 2 + b - a - 1; }

DI unsigned cvtpk(float lo, float hi) { f32x2 v = {lo, hi}; bf16x2_t b = __builtin_convertvector(v, bf16x2_t); return __builtin_bit_cast(unsigned, b); }
DI unsigned pk4_fp8(float a, float b, float c, float d) {
    a = __builtin_fminf(__builtin_fmaxf(a, -448.f), 448.f); b = __builtin_fminf(__builtin_fmaxf(b, -448.f), 448.f); c = __builtin_fminf(__builtin_fmaxf(c, -448.f), 448.f); d = __builtin_fminf(__builtin_fmaxf(d, -448.f), 448.f);
    int w = __builtin_amdgcn_cvt_pk_fp8_f32(a, b, 0, false); w = __builtin_amdgcn_cvt_pk_fp8_f32(c, d, w, true); return (unsigned)w; }
DI unsigned pk4_q8(float a, float b, float c, float d) {
    unsigned w = 0; w = __builtin_amdgcn_cvt_pk_u8_f32(__builtin_fmaxf(a + 128.0f, 1.0f), 0, w); w = __builtin_amdgcn_cvt_pk_u8_f32(__builtin_fmaxf(b + 128.0f, 1.0f), 1, w);
    w = __builtin_amdgcn_cvt_pk_u8_f32(__builtin_fmaxf(c + 128.0f, 1.0f), 2, w); w = __builtin_amdgcn_cvt_pk_u8_f32(__builtin_fmaxf(d + 128.0f, 1.0f), 3, w); return w ^ 0x80808080u; }
DI float i2f(float bits) { return (float)__float_as_int(bits); }
DI float bf2f(unsigned short u) { return __uint_as_float((unsigned)u << 16); }
DI float rs_from(u64 v) { return __builtin_amdgcn_rsqf((float)v * RS_INV + NORM_EPS); }
DI float fast_exp2(float x) { return __builtin_amdgcn_exp2f(x); }
DI float fast_log2(float x) { return __builtin_amdgcn_logf(x); }
DI float fast_rcp(float x) { return __builtin_amdgcn_rcpf(x); }
DI float sigmoidf_(float x) { return fast_rcp(1.0f + fast_exp2(-x * LOG2E)); }
DI float wave_sum(float v) {
#pragma unroll
    for (int o = 1; o < 64; o <<= 1) v += __shfl_xor(v, o);
    return v;
}
DI float wave_max(float v) {
#pragma unroll
    for (int o = 1; o < 64; o <<= 1) v = fmaxf(v, __shfl_xor(v, o));
    return v;
}

namespace pg8 {
constexpr int BM = 256, BK = 64, HALF = 128, HTB = HALF * BK * 2, STAGE_BYTES = 8 * HTB, NXCD = 8, WGM = 8;
__host__ __device__ __forceinline__ int lds_byte(int r, int c) { const int st = (r >> 4) * 2 + (c >> 5), rr = r & 15, cc = c & 31, ob = rr * 64 + cc * 2; return st * 1024 + (ob ^ (((ob >> 9) & 1) << 5)); }
__host__ __device__ __forceinline__ void stage_rc(int b, int& R, int& C) { const int st = b / 1024, sb = b % 1024, swz = sb ^ (((sb >> 9) & 1) << 5); R = (st >> 1) * 16 + swz / 64; C = (st & 1) * 32 + (swz % 64) / 2; }
__host__ __device__ __forceinline__ int perm32(int rho) { const int n = rho >> 4, i = rho & 15; return 8 * (i >> 2) + 4 * n + (i & 3); }

struct Unit { int pm, pn, c, lt, valid; };

DI bool order_next(int i, int G, int c, int nM, int nN, int& pm, int& pn) {
    const int nwg = nM * nN; const long L = (long)i * G + c; if (L >= nwg) return false;
    int wgid = (int)L; { const int q = nwg / NXCD, r = nwg % NXCD, xcd = wgid % NXCD, off = wgid / NXCD; wgid = (xcd < r ? xcd * (q + 1) : r * (q + 1) + (xcd - r) * q) + off; }
    const int nig = WGM * nN, gid = wgid / nig, fm = gid * WGM, gsz = (nM - fm) < WGM ? (nM - fm) : WGM;
    pm = fm + ((wgid % nig) % gsz); pn = (wgid % nig) / gsz; return true;
}
struct DenseSched {
    static constexpr bool GATHER = false, DUAL = false;
    const char* A; const char* Bt; int nM, nN, G, c; size_t tstep;
    DI bool next(int i, Unit& u) const { u.c = 0; u.lt = 0; u.valid = 256; return order_next(i, G, c, nM, nN, u.pm, u.pn); }
    DI const char* a_base(const Unit& u) const { return A + (size_t)u.pm * tstep; }
    DI const char* b_base(const Unit& u) const { return Bt + (size_t)u.pn * tstep; }
    DI void a_offs(const Unit&, int, unsigned (&)[2][2]) const {}
};
template <bool GATHER_> struct MoeSched {
    static constexpr bool GATHER = GATHER_; static constexpr bool DUAL = false;
    const char* A; const char* Bt; const LAS int* tab; const int* tok; int c0, nc, G, c; size_t tstepA, tstepB, estrideB; unsigned rowbytes;
    DI bool next(int i, Unit& u) const {
        const int NT = tab[16 + nc]; int T, pn;
        if (!order_next(i, G, c, NT, 8, T, pn)) return false;
        int cc = 0;
        for (int j = 1; j < nc; ++j) if (T >= tab[16 + j]) cc = j;
        const int lt = T - tab[16 + cc]; const int cnt = tab[c0 + cc];
        u.c = __builtin_amdgcn_readfirstlane(c0 + cc); u.lt = __builtin_amdgcn_readfirstlane(lt); u.valid = __builtin_amdgcn_readfirstlane(min(256, cnt - lt * 256));
        u.pm = __builtin_amdgcn_readfirstlane(tab[33 + c0 + cc] + lt); u.pn = __builtin_amdgcn_readfirstlane(pn); return true;
    }
    DI const char* a_base(const Unit& u) const { return GATHER ? A : A + (size_t)u.pm * tstepA; }
    DI const char* b_base(const Unit& u) const { return Bt + (size_t)(u.c & 7) * estrideB + (size_t)u.pn * tstepB; }
    DI void a_offs(const Unit& u, int tid, unsigned (&off)[2][2]) const {
        asm volatile("" : "+v"(tid)); int R, C; stage_rc(tid * 16, R, C);
#pragma unroll
        for (int h = 0; h < 2; ++h)
#pragma unroll
            for (int i = 0; i < 2; ++i) { const int r = h * HALF + R + 64 * i; const int rr = r < u.valid ? r : 0; const int t = tok[(size_t)u.c * MTOK + u.lt * 256 + rr]; off[h][i] = (unsigned)t * rowbytes + (unsigned)(C * 2); }
    }
};

struct PairSched {
    static constexpr bool GATHER = true, DUAL = true;
    const char* A; const char* Bt; const LAS int* tab; const LAS int* tab2; const int* prefA; const int* prefB; int G, c; size_t tstepB, estrideB; unsigned rowbytes;
    DI bool next(int i, Unit& u) const {
        const int NT = tab2[32 + NPAIR]; int T, pn;
        if (!order_next(i, G, c, NT, 8, T, pn)) return false;
        int cc = 0;
        for (int j = 1; j < NPAIR; ++j) if (T >= tab2[32 + j]) cc = j;
        const int lt = T - tab2[32 + cc]; const int cnt = tab2[cc];
        u.c = __builtin_amdgcn_readfirstlane(cc); u.lt = __builtin_amdgcn_readfirstlane(lt); u.valid = __builtin_amdgcn_readfirstlane(min(256, cnt - lt * 256));
        u.pm = 0; u.pn = __builtin_amdgcn_readfirstlane(pn); return true;
    }
    DI int ea(const Unit& u) const { int a = 0; for (int j = 1; j < 7; ++j) if (u.c >= j * (15 - j) / 2) a = j; return a; }
    DI const char* a_base(const Unit&) const { return A; }
    DI const char* b_base(const Unit& u) const { return Bt + (size_t)ea(u) * estrideB + (size_t)u.pn * tstepB; }
    DI const char* b_base2(const Unit& u) const { const int a = ea(u); const int b = u.c - a * (15 - a) / 2 + a + 1; return Bt + (size_t)b * estrideB + (size_t)u.pn * tstepB; }
    DI void a_offs(const Unit& u, int tid, unsigned (&off)[2][2], unsigned (&off2)[2][2]) const {
        asm volatile("" : "+v"(tid)); int R, C; stage_rc(tid * 16, R, C);
        int ra[2][2], rb[2][2];
#pragma unroll
        for (int h = 0; h < 2; ++h)
#pragma unroll
            for (int i = 0; i < 2; ++i) { const int r = h * HALF + R + 64 * i; const int rr = r < u.valid ? r : 0; const size_t li = (size_t)u.c * MTOK + u.lt * 256 + rr; ra[h][i] = prefA[li]; rb[h][i] = prefB[li]; }
#pragma unroll
        for (int h = 0; h < 2; ++h)
#pragma unroll
            for (int i = 0; i < 2; ++i) { off[h][i] = (unsigned)(tab[33 + (ra[h][i] >> 15)] * 256 + (ra[h][i] & 32767)) * rowbytes + (unsigned)(C * 2); off2[h][i] = (unsigned)(tab[33 + (rb[h][i] >> 15)] * 256 + (rb[h][i] & 32767)) * rowbytes + (unsigned)(C * 2); }
    }
};

template <class Epi, class Sched, int MODE = 0>
DI void gemm_phase(LAS unsigned char* lds, const int KB, const Sched& S, const Epi& E) {
    int tid = threadIdx.x; asm volatile("" : "+v"(tid));
    const int wid = __builtin_amdgcn_readfirstlane(tid >> 6), lane = tid & 63, wr = wid >> 2, wc = wid & 3, fr = lane & 15, fq = lane >> 4;
    const int nt = (Sched::DUAL ? 2 : 1) * (KB / 128);
    unsigned voffA, voffB;
    { int R, C; stage_rc(tid * 16, R, C); const int Rb = Epi::COLMAP ? (64 * (R >> 5) + perm32(R & 31)) : (Epi::PERM ? ((R & ~31) + perm32(R & 31)) : R); voffA = (unsigned)(R * KB + C * 2); voffB = (unsigned)(Rb * KB + C * 2); }
    const size_t pstep = (size_t)64 * KB;
    const size_t pstepB = Epi::COLMAP ? (size_t)128 * KB : (size_t)64 * KB, hstepB = Epi::COLMAP ? (size_t)32 * KB : (size_t)HALF * KB;
    const size_t kstep = (size_t)(BK * 2);
    const size_t hstep = (size_t)HALF * KB;
    const unsigned ldsw = (unsigned)wid * 1024u;
    const int aoff = lds_byte(wr * 64 + fr, fq * 8), boff = lds_byte(wc * 32 + fr, fq * 8);
    unsigned offC[2][2] = {{0u, 0u}, {0u, 0u}}, offN[2][2] = {{0u, 0u}, {0u, 0u}};
    unsigned offC2[2][2] = {{0u, 0u}, {0u, 0u}}, offN2[2][2] = {{0u, 0u}, {0u, 0u}}; (void)offC2; (void)offN2;
#define PG8_SA(b, h) (((b) * 2 + (h)) * HTB)
#define PG8_SB(b, h) ((4 + (b) * 2 + (h)) * HTB)
#define PG8_STAGE(bufoff, gbase, voff) do { _Pragma("unroll") for (int _i = 0; _i < 2; ++_i) \
        __builtin_amdgcn_global_load_lds((const unsigned*)((const char*)(gbase) + _i * pstep + (voff)), (LAS unsigned*)(lds + (bufoff) + ldsw + _i * 8192), 16, 0, 0); } while (0)
#define PG8_STAGE_B(b, h, ptr) do { _Pragma("unroll") for (int _i = 0; _i < 2; ++_i) \
        __builtin_amdgcn_global_load_lds((const unsigned*)((const char*)(ptr) + (h) * hstepB + _i * pstepB + voffB), (LAS unsigned*)(lds + PG8_SB(b, h) + ldsw + _i * 8192), 16, 0, 0); } while (0)
#define PG8_STAGE_G(bufoff, gbase, voff) do { _Pragma("unroll") for (int _i = 0; _i < 2; ++_i) \
        __builtin_amdgcn_global_load_lds((const unsigned*)((const char*)(gbase) + (voff)[_i]), (LAS unsigned*)(lds + (bufoff) + ldsw + _i * 8192), 16, 0, 0); } while (0)
#define PG8_STAGE_A(b, h, ptr, sel) do { if constexpr (Sched::GATHER) { const int _s = (int)(sel); unsigned _o[2] = { _s == 1 ? offN[h][0] : (_s == 2 ? offC2[h][0] : offC[h][0]), _s == 1 ? offN[h][1] : (_s == 2 ? offC2[h][1] : offC[h][1]) }; PG8_STAGE_G(PG8_SA(b, h), ptr, _o); } \
        else { PG8_STAGE(PG8_SA(b, h), (ptr) + (h) * hstep, voffA); } } while (0)
#define PG8_LDA(dst, b, h) do { _Pragma("unroll") for (int m = 0; m < 4; ++m) _Pragma("unroll") for (int k = 0; k < 2; ++k) dst[m][k] = *(const LAS bf16x8*)(lds + PG8_SA(b, h) + aoff + m * 2048 + k * 1024); } while (0)
#define PG8_LDB(dst, b, h) do { _Pragma("unroll") for (int n = 0; n < 2; ++n) _Pragma("unroll") for (int k = 0; k < 2; ++k) dst[n][k] = *(const LAS bf16x8*)(lds + PG8_SB(b, h) + boff + n * 2048 + k * 1024); } while (0)
#define PG8_CAT(x) __builtin_shufflevector(__builtin_bit_cast(i32x4, (x)[0]), __builtin_bit_cast(i32x4, (x)[1]), 0, 1, 2, 3, 4, 5, 6, 7)
#define PG8_MMA(ai, bj, At, Bt) do { __builtin_amdgcn_s_setprio(1); _Pragma("unroll") for (int m = 0; m < 4; ++m) _Pragma("unroll") for (int n = 0; n < 2; ++n) { \
        if constexpr (MODE == 1) { const i32x8 _b = PG8_CAT(Bt[n]), _a = PG8_CAT(At[m]); asm volatile("v_mfma_f32_16x16x128_f8f6f4 %0, %1, %2, %0" : "+v"(acc[ai][bj][m][n]) : "v"(_b), "v"(_a)); } \
        else if constexpr (MODE == 2) { _Pragma("unroll") for (int k = 0; k < 2; ++k) acc[ai][bj][m][n] = __builtin_bit_cast(f32x4, __builtin_amdgcn_mfma_i32_16x16x64_i8(__builtin_bit_cast(i32x4, Bt[n][k]), __builtin_bit_cast(i32x4, At[m][k]), __builtin_bit_cast(i32x4, acc[ai][bj][m][n]), 0, 0, 0)); } \
        else { _Pragma("unroll") for (int k = 0; k < 2; ++k) acc[ai][bj][m][n] = __builtin_amdgcn_mfma_f32_16x16x32_bf16(Bt[n][k], At[m][k], acc[ai][bj][m][n], 0, 0, 0); } } \
        __builtin_amdgcn_s_setprio(0); } while (0)
#define PG8_WAIT_V(n) asm volatile("s_waitcnt vmcnt(" #n ")" ::: "memory")
#define PG8_WAIT_L(n) asm volatile("s_waitcnt lgkmcnt(" #n ")" ::: "memory")
#define PG8_BAR __builtin_amdgcn_s_barrier()
#define PG8_SCHED __builtin_amdgcn_sched_barrier(0)
    Unit cur, nxt; int ui = 0;
    if (!S.next(0, cur)) return;
    f32x4 acc[2][2][4][2];
#pragma unroll
    for (int a = 0; a < 2; ++a)
#pragma unroll
        for (int b = 0; b < 2; ++b)
#pragma unroll
            for (int m = 0; m < 4; ++m)
#pragma unroll
                for (int n = 0; n < 2; ++n) acc[a][b][m][n] = (f32x4){0.f, 0.f, 0.f, 0.f};
    bf16x8 At[4][2], B0[2][2], B1[2][2];
    const char* cA = S.a_base(cur); const char* cB = S.b_base(cur); const char* cB2 = cB; const char* nB2 = cB; (void)cB2; (void)nB2;
    if constexpr (Sched::DUAL) { S.a_offs(cur, tid, offC, offC2); cB2 = S.b_base2(cur); }
    else if constexpr (Sched::GATHER) S.a_offs(cur, tid, offC);
    PG8_STAGE_B(0, 0, cB); PG8_STAGE_B(0, 1, cB); PG8_STAGE_A(0, 0, cA, false); PG8_STAGE_A(0, 1, cA, false);
    if (wr == 1) PG8_BAR;
    PG8_WAIT_V(2); PG8_BAR;
    PG8_STAGE_B(1, 0, cB + kstep); PG8_STAGE_A(1, 0, cA + kstep, false); PG8_STAGE_B(1, 1, cB + kstep);
    PG8_WAIT_V(6); PG8_BAR;
    for (;;) {
        const bool has_next = S.next(ui + 1, nxt);
        const char* nA = has_next ? S.a_base(nxt) : cA; const char* nB = has_next ? S.b_base(nxt) : cB;
        if constexpr (Sched::DUAL) {
            if (has_next) { S.a_offs(nxt, tid, offN, offN2); nB2 = S.b_base2(nxt); }
            else { nB2 = cB2;
#pragma unroll
                for (int h = 0; h < 2; ++h)
#pragma unroll
                    for (int i = 0; i < 2; ++i) { offN[h][i] = offC[h][i]; offN2[h][i] = offC2[h][i]; } }
        } else if constexpr (Sched::GATHER) {
            if (has_next) S.a_offs(nxt, tid, offN);
            else {
#pragma unroll
                for (int h = 0; h < 2; ++h)
#pragma unroll
                    for (int i = 0; i < 2; ++i) offN[h][i] = offC[h][i]; }
        }
        for (int t = 0; t < nt; t += 2) {
            const bool last = (t == nt - 2);
            const int hh = nt >> 1; const bool h1 = Sched::DUAL && (t + 1 >= hh), h2 = Sched::DUAL && (t + 2 >= hh);
            const int s1 = h1 ? 2 : 0, s2 = last ? 1 : (h2 ? 2 : 0);
            const char* a1 = cA + (size_t)(t + 1 - (h1 ? hh : 0)) * kstep;
            const char* a2 = last ? nA : cA + (size_t)(t + 2 - (h2 ? hh : 0)) * kstep; const char* b2 = last ? nB : (h2 ? cB2 : cB) + (size_t)(t + 2 - (h2 ? hh : 0)) * kstep;
            const char* a3 = a2 + kstep; const char* b3 = b2 + kstep;
            PG8_LDB(B0, 0, 0); PG8_LDB(B1, 0, 1); PG8_SCHED; PG8_LDA(At, 0, 0); PG8_STAGE_A(1, 1, a1, s1);
            PG8_WAIT_V(8); PG8_WAIT_L(0); PG8_BAR; PG8_MMA(0, 0, At, B0); PG8_MMA(0, 1, At, B1); PG8_BAR; PG8_SCHED;
            PG8_LDA(At, 0, 1); PG8_STAGE_B(0, 0, b2); PG8_STAGE_B(0, 1, b2); PG8_STAGE_A(0, 0, a2, s2);
            PG8_WAIT_V(8); PG8_WAIT_L(0); PG8_BAR; PG8_MMA(1, 0, At, B0); PG8_MMA(1, 1, At, B1); PG8_BAR; PG8_SCHED;
            PG8_LDB(B0, 1, 0); PG8_LDB(B1, 1, 1); PG8_SCHED; PG8_LDA(At, 1, 0); PG8_STAGE_A(0, 1, a2, s2);
            PG8_WAIT_V(8); PG8_WAIT_L(0); PG8_BAR; PG8_MMA(0, 0, At, B0); PG8_MMA(0, 1, At, B1); PG8_BAR; PG8_SCHED;
            PG8_LDA(At, 1, 1); PG8_STAGE_B(1, 0, b3); PG8_STAGE_B(1, 1, b3); PG8_STAGE_A(1, 0, a3, s2);
            PG8_WAIT_V(8); PG8_WAIT_L(0); PG8_BAR; PG8_MMA(1, 0, At, B0); PG8_MMA(1, 1, At, B1); PG8_BAR; PG8_SCHED;
        }
        if (wr == 0) PG8_BAR;
        if constexpr (MODE == 1) asm volatile("s_nop 15\n\ts_nop 15" ::: "memory");
        { int t2 = tid; asm volatile("" : "+v"(t2)); const int l2 = t2 & 63, w2 = __builtin_amdgcn_readfirstlane(t2 >> 6); E(acc, cur, w2 >> 2, w2 & 3, l2 & 15, l2 >> 4); }
        if (!has_next) break;
#pragma unroll
        for (int a = 0; a < 2; ++a)
#pragma unroll
            for (int b = 0; b < 2; ++b)
#pragma unroll
                for (int m = 0; m < 4; ++m)
#pragma unroll
                    for (int n = 0; n < 2; ++n) acc[a][b][m][n] = (f32x4){0.f, 0.f, 0.f, 0.f};
        cur = nxt; cA = nA; cB = nB; ++ui;
        if constexpr (Sched::DUAL) cB2 = nB2;
        if constexpr (Sched::GATHER) {
#pragma unroll
            for (int h = 0; h < 2; ++h)
#pragma unroll
                for (int i = 0; i < 2; ++i) { offC[h][i] = offN[h][i]; if constexpr (Sched::DUAL) offC2[h][i] = offN2[h][i]; } }
        if (wr == 1) PG8_BAR;
    }
    PG8_WAIT_V(0);
    PG8_BAR;
#undef PG8_SA
#undef PG8_SB
#undef PG8_STAGE
#undef PG8_STAGE_A
#undef PG8_STAGE_G
#undef PG8_STAGE_B
#undef PG8_LDA
#undef PG8_LDB
#undef PG8_MMA
#undef PG8_CAT
#undef PG8_WAIT_V
#undef PG8_WAIT_L
#undef PG8_BAR
#undef PG8_SCHED
}

template <int MODE> struct EpiProj {
    static constexpr bool PERM = true, COLMAP = true;
    bf16_t* proj; const u64* rowss; float* ssq; const float* gq; const float* gk; const u64* rowss_q; const float* wmax;
    DI void operator()(const f32x4 (&acc)[2][2][4][2], const Unit& u, int wr, int wc, int fr, int fq) const {
        const int row0 = u.pm * BM + wr * 64 + fr; const int tcol = wc * 64 + 8 * fq;
        const int dcol = (wc & 1) * 64 + 8 * fq;
        const int pn = u.pn; const int kind = pn < 4 ? 0 : (pn < 12 ? 1 : (pn < 20 ? 2 : (pn < 24 ? 1 : 3)));
        const int hidx = ((pn < 16) ? (pn - 12) * 2 : 8 + (pn - 16) * 2) + (wc >> 1);
        u64 rv[2][4], rq[2][4];
#pragma unroll
        for (int ai = 0; ai < 2; ++ai)
#pragma unroll
            for (int m = 0; m < 4; ++m) { rv[ai][m] = rowss[row0 + ai * HALF + m * 16]; if (MODE == 2) rq[ai][m] = rowss_q[row0 + ai * HALF + m * 16]; }
        f32x4 g[2][2] = {{{1.f, 1.f, 1.f, 1.f}, {1.f, 1.f, 1.f, 1.f}}, {{1.f, 1.f, 1.f, 1.f}, {1.f, 1.f, 1.f, 1.f}}};
        if (kind == 2) { const float* gp = (pn < 16) ? gq : gk;
#pragma unroll
            for (int bj = 0; bj < 2; ++bj) { g[bj][0] = *(const f32x4*)(gp + dcol + 32 * bj); g[bj][1] = *(const f32x4*)(gp + dcol + 32 * bj + 4); } }
        f32x4 wi[2][2] = {{{1.f, 1.f, 1.f, 1.f}, {1.f, 1.f, 1.f, 1.f}}, {{1.f, 1.f, 1.f, 1.f}, {1.f, 1.f, 1.f, 1.f}}};
        if (MODE == 2) { const float* wm = wmax + pn * BM + tcol;
#pragma unroll
            for (int bj = 0; bj < 2; ++bj) { wi[bj][0] = *(const f32x4*)(wm + 32 * bj); wi[bj][1] = *(const f32x4*)(wm + 32 * bj + 4); }
            asm volatile("" ::: "memory");
#pragma unroll
            for (int bj = 0; bj < 2; ++bj) { wi[bj][0] = wi[bj][0] * (1.0f / 127.0f); wi[bj][1] = wi[bj][1] * (1.0f / 127.0f); } }
#pragma unroll
        for (int ai = 0; ai < 2; ++ai)
#pragma unroll
            for (int m = 0; m < 4; ++m) {
                const int row = row0 + ai * HALF + m * 16;
                float rs = rs_from(rv[ai][m]); if (kind == 0) rs *= QK_SCALE2;
                if (MODE == 2) rs *= (Q8_R / 127.0f) / rs_from(rq[ai][m]);
                bf16_t* rowp = proj + (size_t)row * PROJ_N + pn * BM + tcol;
#pragma unroll
                for (int bj = 0; bj < 2; ++bj) {
                    f32x4 v0, v1;
                    if (MODE == 2) {
#pragma unroll
                        for (int k = 0; k < 4; ++k) { v0[k] = i2f(acc[ai][bj][m][0][k]) * wi[bj][0][k]; v1[k] = i2f(acc[ai][bj][m][1][k]) * wi[bj][1][k]; }
                    } else { v0 = acc[ai][bj][m][0]; v1 = acc[ai][bj][m][1]; }
                    v0 = v0 * rs; v1 = v1 * rs;
                    if (kind == 2) {
                        float ss = (v0[0] * v0[0] + v0[1] * v0[1]) + (v0[2] * v0[2] + v0[3] * v0[3]) + (v1[0] * v1[0] + v1[1] * v1[1]) + (v1[2] * v1[2] + v1[3] * v1[3]);
                        ss += __shfl_xor(ss, 16); ss += __shfl_xor(ss, 32);
                        if (fq == 0) ssq[((size_t)row * 16 + hidx) * 4 + (wc & 1) * 2 + bj] = ss;
                        v0 = v0 * g[bj][0]; v1 = v1 * g[bj][1];
                    } else if (kind == 3) {
#pragma unroll
                        for (int k = 0; k < 4; ++k) { v0[k] = sigmoidf_(v0[k]); v1[k] = sigmoidf_(v1[k]); }
                    }
                    u32x4 w; w.x = cvtpk(v0[0], v0[1]); w.y = cvtpk(v0[2], v0[3]); w.z = cvtpk(v1[0], v1[1]); w.w = cvtpk(v1[2], v1[3]);
                    *(u32x4*)(rowp + bj * 32) = w;
                }
            }
    }
};
DI u32x2 bf8x8(const u32x4& w) {
    u32x2 o; o.x = pk4_fp8(__uint_as_float(w.x << 16) * F8_SA, __uint_as_float(w.x & 0xffff0000u) * F8_SA, __uint_as_float(w.y << 16) * F8_SA, __uint_as_float(w.y & 0xffff0000u) * F8_SA);
    o.y = pk4_fp8(__uint_as_float(w.z << 16) * F8_SA, __uint_as_float(w.z & 0xffff0000u) * F8_SA, __uint_as_float(w.w << 16) * F8_SA, __uint_as_float(w.w & 0xffff0000u) * F8_SA); return o; }
DI u32x2 q8x8(const u32x4& w, float sa) {
    u32x2 o; o.x = pk4_q8(__uint_as_float(w.x << 16) * sa, __uint_as_float(w.x & 0xffff0000u) * sa, __uint_as_float(w.y << 16) * sa, __uint_as_float(w.y & 0xffff0000u) * sa);
    o.y = pk4_q8(__uint_as_float(w.z << 16) * sa, __uint_as_float(w.z & 0xffff0000u) * sa, __uint_as_float(w.w << 16) * sa, __uint_as_float(w.w & 0xffff0000u) * sa); return o; }
DI void add8(u32x4& w, const f32x4& a0, const f32x4& a1, float& ss) {
    float v[8] = { __uint_as_float(w.x << 16) + a0[0], __uint_as_float(w.x & 0xffff0000u) + a0[1], __uint_as_float(w.y << 16) + a0[2], __uint_as_float(w.y & 0xffff0000u) + a0[3],
                   __uint_as_float(w.z << 16) + a1[0], __uint_as_float(w.z & 0xffff0000u) + a1[1], __uint_as_float(w.w << 16) + a1[2], __uint_as_float(w.w & 0xffff0000u) + a1[3] };
    ss += ((v[0] * v[0] + v[1] * v[1]) + (v[2] * v[2] + v[3] * v[3])) + ((v[4] * v[4] + v[5] * v[5]) + (v[6] * v[6] + v[7] * v[7]));
    w.x = cvtpk(v[0], v[1]); w.y = cvtpk(v[2], v[3]); w.z = cvtpk(v[4], v[5]); w.w = cvtpk(v[6], v[7]);
}
template <bool W8, int MODE = 0> struct EpiResid {
    static constexpr bool PERM = true, COLMAP = true;
    bf16_t* hb; u64* rowss_out; unsigned char* hb8; float ascale; const u64* rowss_q; const float* wmax; int* xacc; const bf16_t* xw; LAS int* xl;
    DI void operator()(const f32x4 (&acc)[2][2][4][2], const Unit& u, int wr, int wc, int fr, int fq) const {
        const int row0 = u.pm * BM + wr * 64 + fr, col0 = u.pn * BM + wc * 64 + 8 * fq;
        f32x4 wi[2][2] = {{{1.f, 1.f, 1.f, 1.f}, {1.f, 1.f, 1.f, 1.f}}, {{1.f, 1.f, 1.f, 1.f}, {1.f, 1.f, 1.f, 1.f}}};
        bf16x8 xa[2] = {{0, 0, 0, 0, 0, 0, 0, 0}, {0, 0, 0, 0, 0, 0, 0, 0}};
#pragma unroll
        for (int ai = 0; ai < 2; ++ai) {
        u32x4 w[4][2];
#pragma unroll
        for (int m = 0; m < 4; ++m) { const bf16_t* p = hb + (size_t)(row0 + ai * HALF + m * 16) * DM + col0; w[m][0] = *(const u32x4*)p; w[m][1] = *(const u32x4*)(p + 32); }
        u64 rq[4];
        if (W8) {
#pragma unroll
            for (int m = 0; m < 4; ++m) rq[m] = rowss_q[row0 + ai * HALF + m * 16]; }
        if (ai == 0) {
            f32x4 wr_[2][2];
            if (MODE == 2) {
#pragma unroll
                for (int bj = 0; bj < 2; ++bj) { wr_[bj][0] = *(const f32x4*)(wmax + col0 + 32 * bj); wr_[bj][1] = *(const f32x4*)(wmax + col0 + 32 * bj + 4); } }
            if (xacc && fr < 8) { xa[0] = *(const bf16x8*)(xw + (size_t)fr * DM + col0); xa[1] = *(const bf16x8*)(xw + (size_t)fr * DM + col0 + 32); }
            asm volatile("" ::: "memory");
            if (MODE == 2) {
#pragma unroll
                for (int bj = 0; bj < 2; ++bj) { wi[bj][0] = wr_[bj][0] * (ascale / 127.0f); wi[bj][1] = wr_[bj][1] * (ascale / 127.0f); } }
        }
        asm volatile("" ::: "memory");
#pragma unroll
            for (int m = 0; m < 4; ++m) {
                const int row = row0 + ai * HALF + m * 16; bf16_t* p = hb + (size_t)row * DM + col0; float ss = 0.f;
                u32x4 w0 = w[m][0], w1 = w[m][1];
                if (MODE == 2) { f32x4 t[2][2];
#pragma unroll
                    for (int bj = 0; bj < 2; ++bj)
#pragma unroll
                        for (int n = 0; n < 2; ++n)
#pragma unroll
                            for (int k = 0; k < 4; ++k) t[bj][n][k] = i2f(acc[ai][bj][m][n][k]) * wi[bj][n][k];
                    add8(w0, t[0][0], t[0][1], ss); add8(w1, t[1][0], t[1][1], ss); }
                else { add8(w0, acc[ai][0][m][0] * ascale, acc[ai][0][m][1] * ascale, ss); add8(w1, acc[ai][1][m][0] * ascale, acc[ai][1][m][1] * ascale, ss); }
                *(u32x4*)p = w0; *(u32x4*)(p + 32) = w1;
                if (xacc) { f32x4 d = {0.f, 0.f, 0.f, 0.f};
                    d = __builtin_amdgcn_mfma_f32_16x16x32_bf16(xa[0], __builtin_bit_cast(bf16x8, w0), d, 0, 0, 0); d = __builtin_amdgcn_mfma_f32_16x16x32_bf16(xa[1], __builtin_bit_cast(bf16x8, w1), d, 0, 0, 0);
                    if (fq < 2) {
#pragma unroll
                        for (int r = 0; r < 4; ++r) __hip_atomic_fetch_add(xl + (wr * 64 + fr + ai * HALF + m * 16) * 8 + 4 * fq + r, (int)__builtin_rintf(d[r] * XFIX), __ATOMIC_RELAXED, __HIP_MEMORY_SCOPE_WORKGROUP); } }
                if (W8) { const float sa = rs_from(rq[m]) * (127.0f / Q8_R); unsigned char* q = hb8 + (size_t)row * DM + col0; *(u32x2*)q = GU_MODE == 2 ? q8x8(w0, sa) : bf8x8(w0); *(u32x2*)(q + 32) = GU_MODE == 2 ? q8x8(w1, sa) : bf8x8(w1); }
                ss += __shfl_xor(ss, 16); ss += __shfl_xor(ss, 32);
                if (fq == 0) __hip_atomic_fetch_add(rowss_out + row, (u64)(ss * RS_FIX), __ATOMIC_RELAXED, __HIP_MEMORY_SCOPE_AGENT);
            }
        asm volatile("" ::: "memory");
        }
        if (xacc) {
            asm volatile("s_waitcnt lgkmcnt(0)" ::: "memory"); __builtin_amdgcn_s_barrier(); asm volatile("" ::: "memory");
            const int t = (wr * 4 + wc) * 64 + fq * 16 + fr; const i32x4 v = *(const LAS i32x4*)(xl + 4 * t);
            *(i32x4*)(xacc + (size_t)u.pn * XPLANE + (size_t)u.pm * BM * 8 + 4 * t) = v; *(LAS i32x4*)(xl + 4 * t) = (i32x4){0, 0, 0, 0};
        }
    }
};
template <bool MOE, int MODE = 1> struct EpiSwiglu {
    static constexpr bool PERM = true, COLMAP = false;
    unsigned char* act; int ldo; const u64* rowss; const int* tok; const u64* rowss_q; const float* wmax; const float* rsl = nullptr; const float* gatel = nullptr;
    DI void operator()(const f32x4 (&acc)[2][2][4][2], const Unit& u, int wr, int wc, int fr, int fq) const {
        const int r0 = wr * 64 + fr; const int col = u.pn * HALF + wc * 32 + 8 * fq;
        int srow[2][4]; u64 rsv[2][4], rqv[2][4]; float rsm[2][4], gtm[2][4];
        constexpr bool LISTED = MOE && MODE == 2;
#pragma unroll
        for (int ai = 0; ai < 2; ++ai)
#pragma unroll
            for (int m = 0; m < 4; ++m) { const int r = r0 + ai * HALF + m * 16; srow[ai][m] = u.pm * BM + r; rsm[ai][m] = 0.f; gtm[ai][m] = 1.f;
                if (MOE) { const int rr = r < u.valid ? r : 0; if (LISTED) { rsm[ai][m] = rsl[(size_t)u.c * MTOK + u.lt * 256 + rr]; gtm[ai][m] = gatel[(size_t)u.c * MTOK + u.lt * 256 + rr]; } else srow[ai][m] = tok[(size_t)u.c * MTOK + u.lt * 256 + rr]; } }
        if (!LISTED) {
#pragma unroll
        for (int ai = 0; ai < 2; ++ai)
#pragma unroll
            for (int m = 0; m < 4; ++m) { rsv[ai][m] = rowss[srow[ai][m]]; if (MODE == 2) rqv[ai][m] = rowss_q[srow[ai][m]]; } }
        f32x4 wg[2] = {{1.f, 1.f, 1.f, 1.f}, {1.f, 1.f, 1.f, 1.f}}, wu[2] = {{1.f, 1.f, 1.f, 1.f}, {1.f, 1.f, 1.f, 1.f}};
        if (MODE == 2) { const float* wm = wmax + (MOE ? (u.c & 7) * 2048 : 0) + u.pn * BM + wc * 32 + 8 * fq;
            wg[0] = *(const f32x4*)wm * (1.0f / 127.0f); wg[1] = *(const f32x4*)(wm + 4) * (1.0f / 127.0f); wu[0] = *(const f32x4*)(wm + HALF) * (1.0f / 127.0f); wu[1] = *(const f32x4*)(wm + HALF + 4) * (1.0f / 127.0f); }
#pragma unroll
        for (int ai = 0; ai < 2; ++ai)
#pragma unroll
            for (int m = 0; m < 4; ++m) {
                const int r = r0 + ai * HALF + m * 16;
                float rs;
                if (LISTED) rs = rsm[ai][m];
                else { rs = rs_from(rsv[ai][m]);
                if (MODE == 1) rs *= 1.0f / (F8_SA * F8_SW);
                if (MODE == 2) rs *= (Q8_R / 127.0f) / rs_from(rqv[ai][m]); }
                const float ru = rs * (MODE ? F8_SACT : 1.0f) * (LISTED ? gtm[ai][m] : 1.0f);
                f32x4 ga, gb, ua, ub;
                if (MODE == 2) {
#pragma unroll
                    for (int k = 0; k < 4; ++k) { ga[k] = i2f(acc[ai][0][m][0][k]) * wg[0][k]; gb[k] = i2f(acc[ai][0][m][1][k]) * wg[1][k]; ua[k] = i2f(acc[ai][1][m][0][k]) * wu[0][k]; ub[k] = i2f(acc[ai][1][m][1][k]) * wu[1][k]; }
                } else { ga = acc[ai][0][m][0]; gb = acc[ai][0][m][1]; ua = acc[ai][1][m][0]; ub = acc[ai][1][m][1]; }
                ga = ga * rs; gb = gb * rs; ua = ua * ru; ub = ub * ru;
                float o[8];
#pragma unroll
                for (int k = 0; k < 4; ++k) { o[k] = ga[k] * sigmoidf_(ga[k]) * ua[k]; o[4 + k] = gb[k] * sigmoidf_(gb[k]) * ub[k]; }
                if (MODE) { u32x2 w; w.x = pk4_fp8(o[0], o[1], o[2], o[3]); w.y = pk4_fp8(o[4], o[5], o[6], o[7]); *(u32x2*)(act + (size_t)(u.pm * BM + r) * ldo + col) = w; }
                else { u32x4 w; w.x = cvtpk(o[0], o[1]); w.y = cvtpk(o[2], o[3]); w.z = cvtpk(o[4], o[5]); w.w = cvtpk(o[6], o[7]); *(u32x4*)((bf16_t*)act + (size_t)(u.pm * BM + r) * ldo + col) = w; }
            }
    }
};
template <bool FINAL> struct EpiMoeDown {
    static constexpr bool PERM = true, COLMAP = true;
    bf16_t* hb; u64* rowss_out; const int* tok; const float* gate; float ascale; unsigned char* hb8; const u64* rowss_q; int* xacc; const bf16_t* xw; LAS int* xl;
    DI void operator()(const f32x4 (&acc)[2][2][4][2], const Unit& u, int wr, int wc, int fr, int fq) const {
        const int r0 = wr * 64 + fr, col0 = u.pn * BM + wc * 64 + 8 * fq;
        bf16x8 xa[2] = {{0, 0, 0, 0, 0, 0, 0, 0}, {0, 0, 0, 0, 0, 0, 0, 0}};
        if (FINAL && xacc && fr < 8) { xa[0] = *(const bf16x8*)(xw + (size_t)fr * DM + col0); xa[1] = *(const bf16x8*)(xw + (size_t)fr * DM + col0 + 32); }
        int rowv[2][4]; float gtv[2][4];
#pragma unroll
        for (int ai = 0; ai < 2; ++ai)
#pragma unroll
            for (int m = 0; m < 4; ++m) { const int r = r0 + ai * HALF + m * 16; const size_t li = (size_t)u.c * MTOK + u.lt * 256 + (r < u.valid ? r : 0); rowv[ai][m] = tok[li]; gtv[ai][m] = gate ? gate[li] : 1.0f; }
#pragma unroll
        for (int ai = 0; ai < 2; ++ai) {
        u32x4 w[4][2];
#pragma unroll
        for (int m = 0; m < 4; ++m) { const bf16_t* p = hb + (size_t)rowv[ai][m] * DM + col0; w[m][0] = *(const u32x4*)p; w[m][1] = *(const u32x4*)(p + 32); }
        u64 rq[4];
        if (FINAL && G1_MODE == 2) {
#pragma unroll
            for (int m = 0; m < 4; ++m) rq[m] = rowss_q[rowv[ai][m]]; }
        asm volatile("" ::: "memory");
#pragma unroll
            for (int m = 0; m < 4; ++m) {
                const int r = r0 + ai * HALF + m * 16; const int r_ = r; const bool ok = r < u.valid;
                const int row = rowv[ai][m]; const float gt = gtv[ai][m] * ascale; bf16_t* p = hb + (size_t)row * DM + col0; float ss = 0.f;
                if (ok) {
                    u32x4 w0 = w[m][0], w1 = w[m][1];
                    add8(w0, acc[ai][0][m][0] * gt, acc[ai][0][m][1] * gt, ss); add8(w1, acc[ai][1][m][0] * gt, acc[ai][1][m][1] * gt, ss);
                    *(u32x4*)p = w0; *(u32x4*)(p + 32) = w1;
                    if (FINAL && G1_MODE == 2) { const float sa = rs_from(rq[m]) * (127.0f / Q8_R); unsigned char* q = hb8 + (size_t)row * DM + col0; *(u32x2*)q = q8x8(w0, sa); *(u32x2*)(q + 32) = q8x8(w1, sa); }
                    w[m][0] = w0; w[m][1] = w1;
                }
                if (FINAL && xacc) { f32x4 d = {0.f, 0.f, 0.f, 0.f};
                    d = __builtin_amdgcn_mfma_f32_16x16x32_bf16(xa[0], __builtin_bit_cast(bf16x8, w[m][0]), d, 0, 0, 0); d = __builtin_amdgcn_mfma_f32_16x16x32_bf16(xa[1], __builtin_bit_cast(bf16x8, w[m][1]), d, 0, 0, 0);
                    if (fq < 2 && ok) {
#pragma unroll
                        for (int r = 0; r < 4; ++r) __hip_atomic_fetch_add(xl + r_ * 8 + 4 * fq + r, (int)__builtin_rintf(d[r] * XFIX), __ATOMIC_RELAXED, __HIP_MEMORY_SCOPE_WORKGROUP); } }
                if (FINAL) { ss += __shfl_xor(ss, 16); ss += __shfl_xor(ss, 32);
                    if (fq == 0 && ok) __hip_atomic_fetch_add(rowss_out + row, (u64)(ss * RS_FIX), __ATOMIC_RELAXED, __HIP_MEMORY_SCOPE_AGENT); }
            }
        asm volatile("" ::: "memory");
        }
        if (FINAL && xacc) {
            asm volatile("s_waitcnt lgkmcnt(0)" ::: "memory"); __builtin_amdgcn_s_barrier(); asm volatile("" ::: "memory");
            const int t = (wr * 4 + wc) * 64 + fq * 16 + fr; const int rl = t >> 1; const i32x4 v = *(const LAS i32x4*)(xl + 4 * t);
            if (rl < u.valid) { const int trow = tok[(size_t)u.c * MTOK + u.lt * 256 + rl]; *(i32x4*)(xacc + (size_t)u.pn * XPLANE + (size_t)trow * 8 + 4 * (t & 1)) = v; }
            *(LAS i32x4*)(xl + 4 * t) = (i32x4){0, 0, 0, 0};
        }
    }
};
}

#define XB_TMO      128
#define XB_XCNT(j)  (256  + 64 * (j))
#define XB_XSUB(j)  (1280 + 64 * (j))
#define XB_XGEN(j)  (2304 + 64 * (j))
#define XB_TOP      3328
#define XB_TOPGEN   3392
#define XCD_BAR_WORDS 3456
#define XB_SPIN_CAP (1u << 18)
DI unsigned xb_ld(unsigned* p)              { return __hip_atomic_load(p, __ATOMIC_RELAXED, __HIP_MEMORY_SCOPE_AGENT); }
DI unsigned xb_add(unsigned* p, unsigned v) { return __hip_atomic_fetch_add(p, v, __ATOMIC_RELAXED, __HIP_MEMORY_SCOPE_AGENT); }
DI unsigned xb_xcc_id() { return (unsigned)__builtin_amdgcn_s_getreg((3 << 11) | 20) & 0xFu; }
#define XB_SPIN(cond, bar) do { unsigned _sp = 0; while (cond) { __builtin_amdgcn_s_sleep(1); \
    if ((++_sp & 255u) == 0u) { if (xb_ld(&(bar)[XB_TMO])) break; if (_sp > XB_SPIN_CAP) { atomicAdd(&(bar)[XB_TMO], 1u); break; } } } } while (0)
struct XcdBarrier { unsigned* bar; unsigned x; volatile LAS unsigned* st; };
DI XcdBarrier xcd_barrier_post(unsigned* bar, volatile LAS unsigned* st) {
    XcdBarrier b; b.bar = bar; b.x = xb_xcc_id(); b.st = st;
    if (threadIdx.x == 0) (void)xb_add(&bar[XB_XCNT(b.x)], 1u);
    return b;
}
DI void xcd_barrier_complete(unsigned* bar, unsigned x, unsigned& nloc, unsigned& nx) {
    const unsigned G = gridDim.x * gridDim.y * gridDim.z;
    unsigned sum, cnt, mine, sp = 0u;
    for (;;) {
        sum = 0u; cnt = 0u; mine = 0u;
#pragma unroll
        for (unsigned j = 0; j < 16; ++j) { const unsigned c = xb_ld(&bar[XB_XCNT(j)]); sum += c; cnt += (c > 0u) ? 1u : 0u; mine = (j == x) ? c : mine; }
        if (sum == G) break;
        __builtin_amdgcn_s_sleep(1);
        if ((++sp & 255u) == 0u) { if (xb_ld(&bar[XB_TMO])) break; if (sp > XB_SPIN_CAP) { atomicAdd(&bar[XB_TMO], 1u); break; } }
    }
    nloc = mine > 0u ? mine : 1u; nx = cnt > 0u ? cnt : 1u;
}
DI void xcd_barrier(const XcdBarrier& b) {
    asm volatile("s_waitcnt vmcnt(0)" ::: "memory");
    __syncthreads();
    if (threadIdx.x == 0) {
        unsigned* bar = b.bar;
        __builtin_amdgcn_s_waitcnt(0);
        unsigned nloc = b.st[0], nx = b.st[1];
        if (nloc == 0u) { xcd_barrier_complete(bar, b.x, nloc, nx); b.st[0] = nloc; b.st[1] = nx; }
        const unsigned old = xb_add(&bar[XB_XSUB(b.x)], 1u);
        const unsigned gen = old / nloc;
        if (old + 1u == (gen + 1u) * nloc) {
            __builtin_amdgcn_fence(__ATOMIC_RELEASE, "agent");
            asm volatile("s_waitcnt vmcnt(0)" ::: "memory");
            const unsigned og = xb_add(&bar[XB_TOP], 1u);
            const unsigned tg = og / nx;
            if (og + 1u == (tg + 1u) * nx) xb_add(&bar[XB_TOPGEN], 1u);
            else XB_SPIN(xb_ld(&bar[XB_TOPGEN]) == tg, bar);
            __builtin_amdgcn_fence(__ATOMIC_ACQUIRE, "agent");
            xb_add(&bar[XB_XGEN(b.x)], 1u);
            asm volatile("s_waitcnt vmcnt(0)" ::: "memory");
        } else {
            XB_SPIN(xb_ld(&bar[XB_XGEN(b.x)]) == gen, bar);
            __builtin_amdgcn_fence(__ATOMIC_ACQUIRE, "agent");
            asm volatile("s_waitcnt vmcnt(0)" ::: "memory");
        }
    }
    __syncthreads();
}

struct Args {
    const float* x; const float* attn_norm; const float* w_in; const float* b_forget; const float* fox_q_norm; const float* fox_k_norm; const float* sb_out_norm; const float* fox_out_norm;
    const float* w_out; const float* ffn_norm; const float* dense_w_gate; const float* dense_w_up; const float* dense_w_down; const float* router_w; const float* moe_w_gate; const float* moe_w_up;
    const float* moe_w_down; const float* final_norm; float* out; unsigned char* ws; int lo, hi;
};

DI int opaque_tid() { int t = threadIdx.x; asm volatile("" : "+v"(t)); return t; }
typedef const __attribute__((address_space(4))) Args* CArgsP;
typedef const __attribute__((address_space(4))) u64* CU64P;
static_assert(sizeof(Args) == 21 * 8, "Args is 21 u64 words, no padding");
DI Args args_here() { CU64P p = (CU64P)__builtin_amdgcn_kernarg_segment_ptr(); asm volatile("" : "+s"(p)); Args a; u64* d = (u64*)&a;
#pragma unroll
    for (int i = 0; i < 20; ++i) { GAS unsigned char* g = (GAS unsigned char*)p[i]; unsigned char* f = (unsigned char*)g; d[i] = (u64)f; }
    d[20] = p[20];
    return a; }
DI void transpose_item(const float* W, int ld, int K, int k0, int n0, const float* gain, bf16_t* WT, int dst_row0, LAS float* scr, int lane) {
    { float v[32], gn[32];
#pragma unroll
    for (int i = 0; i < 32; ++i) { const int kk = 2 * i + (lane >> 5); v[i] = W[(size_t)(k0 + kk) * ld + n0 + (lane & 31)]; gn[i] = gain ? gain[k0 + kk] : 1.0f; }
#pragma unroll
    for (int i = 0; i < 32; ++i) { const int kk = 2 * i + (lane >> 5); scr[kk * 33 + (lane & 31)] = v[i] * gn[i]; } }
    asm volatile("s_waitcnt lgkmcnt(0)" ::: "memory");
    const int c = lane & 7;
#pragma unroll
    for (int j = 0; j < 4; ++j) { const int n = (lane >> 3) + 8 * j; const LAS float* s = scr + (8 * c) * 33 + n;
        u32x4 o; o.x = cvtpk(s[0 * 33], s[1 * 33]); o.y = cvtpk(s[2 * 33], s[3 * 33]); o.z = cvtpk(s[4 * 33], s[5 * 33]); o.w = cvtpk(s[6 * 33], s[7 * 33]);
        *(u32x4*)(WT + (size_t)(dst_row0 + n) * K + k0 + 8 * c) = o; }
    asm volatile("s_waitcnt lgkmcnt(0)" ::: "memory");
}
DI void transpose_item8(const float* W, int ld, int K, int k0, int n0, const float* gain, unsigned char* WT, int dst_row0, LAS float* scr, int lane) {
    { f32x4 v[8]; float gn[8];
      const int r = lane >> 3, c4 = lane & 7;
#pragma unroll
      for (int i = 0; i < 8; ++i) { const int kk = 8 * i + r; v[i] = *(const f32x4*)(W + (size_t)(k0 + kk) * ld + n0 + 4 * c4); gn[i] = gain ? gain[k0 + kk] * F8_SW : F8_SW; }
#pragma unroll
      for (int i = 0; i < 8; ++i) { const int kk = 8 * i + r;
#pragma unroll
          for (int j = 0; j < 4; ++j) scr[kk * 33 + 4 * c4 + j] = v[i][j] * gn[i]; } }
    asm volatile("s_waitcnt lgkmcnt(0)" ::: "memory");
    const int c = lane & 7;
#pragma unroll
    for (int j = 0; j < 4; ++j) { const int n = (lane >> 3) + 8 * j; const LAS float* s = scr + (8 * c) * 33 + n;
        u32x2 o; o.x = pk4_fp8(s[0 * 33], s[1 * 33], s[2 * 33], s[3 * 33]); o.y = pk4_fp8(s[4 * 33], s[5 * 33], s[6 * 33], s[7 * 33]);
        *(u32x2*)(WT + (size_t)(dst_row0 + n) * K + k0 + 8 * c) = o; }
    asm volatile("s_waitcnt lgkmcnt(0)" ::: "memory");
}
DI void transpose_item_q8(const float* W, int ld, int K, int k0, int n0, const float* gain, unsigned char* WT, int dst_row0, const float* wmax, LAS float* scr, int lane) {
    { float v[32], gn[32];
#pragma unroll
    for (int i = 0; i < 32; ++i) { const int kk = 2 * i + (lane >> 5); v[i] = W[(size_t)(k0 + kk) * ld + n0 + (lane & 31)]; gn[i] = gain ? gain[k0 + kk] : 1.0f; }
#pragma unroll
    for (int i = 0; i < 32; ++i) { const int kk = 2 * i + (lane >> 5); scr[kk * 33 + (lane & 31)] = v[i] * gn[i]; } }
    asm volatile("s_waitcnt lgkmcnt(0)" ::: "memory");
    const int c = lane & 7;
#pragma unroll
    for (int j = 0; j < 4; ++j) { const int n = (lane >> 3) + 8 * j; const LAS float* s = scr + (8 * c) * 33 + n; const float sw = 127.0f / __builtin_fmaxf(wmax[dst_row0 + n], 1e-30f);
        u32x2 o; o.x = pk4_q8(s[0 * 33] * sw, s[1 * 33] * sw, s[2 * 33] * sw, s[3 * 33] * sw); o.y = pk4_q8(s[4 * 33] * sw, s[5 * 33] * sw, s[6 * 33] * sw, s[7 * 33] * sw);
        *(u32x2*)(WT + (size_t)(dst_row0 + n) * K + k0 + 8 * c) = o; }
    asm volatile("s_waitcnt lgkmcnt(0)" ::: "memory");
}
DI void wmax_item(const float* W, int ld, int k0, int n0, const float* gain, float* wmax, int dst_row0, int lane) {
    float v[32], gn[32];
#pragma unroll
    for (int i = 0; i < 32; ++i) { const int kk = 2 * i + (lane >> 5); v[i] = W[(size_t)(k0 + kk) * ld + n0 + (lane & 31)]; gn[i] = gain ? gain[k0 + kk] : 1.0f; }
    float m = 0.f;
#pragma unroll
    for (int i = 0; i < 32; ++i) m = __builtin_fmaxf(m, __builtin_fabsf(v[i] * gn[i]));
    m = __builtin_fmaxf(m, __shfl_xor(m, 32));
    if (lane < 32) __hip_atomic_fetch_max((unsigned*)(wmax + dst_row0 + lane), __float_as_uint(m), __ATOMIC_RELAXED, __HIP_MEMORY_SCOPE_AGENT);
}
DI int dst_row_of(int mode, int n0) { return mode == 0 ? n0 : (n0 / 128) * 256 + (n0 % 128) + (mode == 2 ? 128 : 0); }
DI void convert_mat_item(const float* W, int ld, int K, int N, const float* gain, bf16_t* WT, int mode, int item, LAS float* scr, int lane) {
    const int nblk = N / 32, kb = item / nblk, nb = item % nblk, n0 = 32 * nb;
    const int dst = mode == 0 ? n0 : (n0 / 128) * 256 + (n0 % 128) + (mode == 2 ? 128 : 0);
    transpose_item(W, ld, K, 64 * kb, n0, gain, WT, dst, scr, lane);
}
DI void convert_mat_item_q8(const float* W, int ld, int K, int N, const float* gain, unsigned char* WT, int mode, int item, const float* wmax, LAS float* scr, int lane) {
    const int nblk = N / 32, kb = item / nblk, nb = item % nblk, n0 = 32 * nb;
    transpose_item_q8(W, ld, K, 64 * kb, n0, gain, WT, dst_row_of(mode, n0), wmax, scr, lane);
}
DI void wmax_mat_item(const float* W, int ld, int N, const float* gain, float* wmax, int mode, int item, int lane) {
    const int nblk = N / 32, kb = item / nblk, nb = item % nblk, n0 = 32 * nb;
    wmax_item(W, ld, 64 * kb, n0, gain, wmax, dst_row_of(mode, n0), lane);
}
DI void convert_mat_item8(const float* W, int ld, int K, int N, const float* gain, unsigned char* WT, int mode, int item, LAS float* scr, int lane) {
    const int nblk = N / 32, kb = item / nblk, nb = item % nblk, n0 = 32 * nb;
    const int dst = mode == 0 ? n0 : (n0 / 128) * 256 + (n0 % 128) + (mode == 2 ? 128 : 0);
    transpose_item8(W, ld, K, 64 * kb, n0, gain, WT, dst, scr, lane);
}
#ifndef GU_MODE
#define GU_MODE 2
#endif
DI void wmax_layer(const Args& a, int l, int gw, int NGW, int lane) {
    float* wm = (float*)(a.ws + WS_WMAX) + (size_t)l * WMAX_LAYER; const float* fn = a.ffn_norm + l * DM; const int li = l >> 1;
    if (G1_MODE == 2) { const float* w_in = a.w_in + (size_t)l * DM * P_IN; const float* an = a.attn_norm + l * DM; constexpr int I_IN = 32 * 224;
        for (int it = gw; it < I_IN; it += NGW) wmax_mat_item(w_in, P_IN, PROJ_N, an, wm + WMAX_IN, 0, it, lane); }
    if (G2_MODE == 2) { const float* w_out = a.w_out + (size_t)l * DM * DM; constexpr int I_OUT = 32 * 64;
        for (int it = gw; it < I_OUT; it += NGW) wmax_mat_item(w_out, DM, DM, nullptr, wm + WMAX_OUT, 0, it, lane); }
    if (GU_MODE != 2) return;
    if ((l & 1) == 0) {
        const float* wg = a.dense_w_gate + (size_t)li * DM * DFF; const float* wu = a.dense_w_up + (size_t)li * DM * DFF; constexpr int I_G = 32 * 176;
        for (int it = gw; it < 2 * I_G; it += NGW) { if (it < I_G) wmax_mat_item(wg, DFF, DFF, fn, wm + WMAX_GU, 1, it, lane); else wmax_mat_item(wu, DFF, DFF, fn, wm + WMAX_GU, 2, it - I_G, lane); }
    } else {
        const float* wg = a.moe_w_gate + (size_t)li * NE * DM * DFE; const float* wu = a.moe_w_up + (size_t)li * NE * DM * DFE; constexpr int I_E = 32 * 32;
        for (int it = gw; it < 2 * NE * I_E; it += NGW) { const int kind = it / (NE * I_E), e = (it / I_E) % NE, ri = it % I_E;
            wmax_mat_item((kind ? wu : wg) + (size_t)e * DM * DFE, DFE, DFE, fn, wm + WMAX_GU + e * 2048, kind ? 2 : 1, ri, lane); }
    }
}
#ifndef DENSE_F8_MASK
#define DENSE_F8_MASK 3
#endif
#define DENSE_IS_F8(l) (((DENSE_F8_MASK) >> ((l) >> 1)) & 1)
DI void convert_layer(const Args& a, int l, LAS float* scr, int gw, int NGW, int lane) {
    unsigned char* slot = a.ws + WS_WBUF + (size_t)(l & 1) * WSLOT;
    bf16_t* Win_t = (bf16_t*)(slot + WO_WIN); bf16_t* Wf_t = (bf16_t*)(slot + WO_WF); bf16_t* Wr_t = (bf16_t*)(slot + WO_WR); bf16_t* Wout_t = (bf16_t*)(slot + WO_WOUT);
    unsigned char* Wgu_t = slot + WO_FFN_GU;
    const float* w_in = a.w_in + (size_t)l * DM * P_IN; const float* w_out = a.w_out + (size_t)l * DM * DM;
    const float* an = a.attn_norm + l * DM; const float* fn = a.ffn_norm + l * DM; const int li = l >> 1;
    const float* wmx = (const float*)(a.ws + WS_WMAX) + (size_t)l * WMAX_LAYER;
    constexpr int I_IN = 32 * 224, I_OUT = 32 * 64;
    if ((l & 1) == 0) {
        unsigned char* Wd_t = slot + WO_DENSE_D;
        const float* wg = a.dense_w_gate + (size_t)li * DM * DFF; const float* wu = a.dense_w_up + (size_t)li * DM * DFF; const float* wd = a.dense_w_down + (size_t)li * DFF * DM;
        constexpr int I_G = 32 * 176, I_D = 88 * 64, NIT = I_IN + I_OUT + 2 * I_G + I_D;
        for (int it = gw; it < NIT; it += NGW) {
            int r = it;
            if (r < I_IN) { if (G1_MODE == 2) convert_mat_item_q8(w_in, P_IN, DM, PROJ_N, an, (unsigned char*)Win_t, 0, r, wmx + WMAX_IN, scr, lane); else convert_mat_item(w_in, P_IN, DM, PROJ_N, an, Win_t, 0, r, scr, lane); continue; } r -= I_IN;
            if (r < I_OUT) { if (G2_MODE == 2) convert_mat_item_q8(w_out, DM, DM, DM, nullptr, (unsigned char*)Wout_t, 0, r, wmx + WMAX_OUT, scr, lane); else convert_mat_item(w_out, DM, DM, DM, nullptr, Wout_t, 0, r, scr, lane); continue; } r -= I_OUT;
            if (DENSE_IS_F8(l)) {
            if (r < I_G) { if (GU_MODE == 2) convert_mat_item_q8(wg, DFF, DM, DFF, fn, Wgu_t, 1, r, wmx + WMAX_GU, scr, lane); else convert_mat_item8(wg, DFF, DM, DFF, fn, Wgu_t, 1, r, scr, lane); continue; } r -= I_G;
            if (r < I_G) { if (GU_MODE == 2) convert_mat_item_q8(wu, DFF, DM, DFF, fn, Wgu_t, 2, r, wmx + WMAX_GU, scr, lane); else convert_mat_item8(wu, DFF, DM, DFF, fn, Wgu_t, 2, r, scr, lane); continue; } r -= I_G;
            convert_mat_item8(wd, DM, DFF, DM, nullptr, Wd_t, 0, r, scr, lane);
            } else {
            if (r < I_G) { convert_mat_item(wg, DFF, DM, DFF, fn, (bf16_t*)Wgu_t, 1, r, scr, lane); continue; } r -= I_G;
            if (r < I_G) { convert_mat_item(wu, DFF, DM, DFF, fn, (bf16_t*)Wgu_t, 2, r, scr, lane); continue; } r -= I_G;
            convert_mat_item(wd, DM, DFF, DM, nullptr, (bf16_t*)Wd_t, 0, r, scr, lane);
            }
        }
    } else {
        unsigned char* Wd_t = slot + WO_MOE_D;
        const float* wg = a.moe_w_gate + (size_t)li * NE * DM * DFE; const float* wu = a.moe_w_up + (size_t)li * NE * DM * DFE; const float* wd = a.moe_w_down + (size_t)li * NE * DFE * DM;
        constexpr int I_E = 32 * 32, I_ED = 16 * 64, NIT = I_IN + I_OUT + 3 * NE * I_E;
        static_assert(I_E == I_ED, "expert item counts");
        for (int it = gw; it < NIT; it += NGW) {
            int r = it;
            if (r < I_IN) { if (G1_MODE == 2) convert_mat_item_q8(w_in, P_IN, DM, PROJ_N, an, (unsigned char*)Win_t, 0, r, wmx + WMAX_IN, scr, lane); else convert_mat_item(w_in, P_IN, DM, PROJ_N, an, Win_t, 0, r, scr, lane); continue; } r -= I_IN;
            if (r < I_OUT) { if (G2_MODE == 2) convert_mat_item_q8(w_out, DM, DM, DM, nullptr, (unsigned char*)Wout_t, 0, r, wmx + WMAX_OUT, scr, lane); else convert_mat_item(w_out, DM, DM, DM, nullptr, Wout_t, 0, r, scr, lane); continue; } r -= I_OUT;
            const int kind = r / (NE * I_E), e = (r / I_E) % NE, ri = r % I_E;
            if (kind == 0) { if (GU_MODE == 2) convert_mat_item_q8(wg + (size_t)e * DM * DFE, DFE, DM, DFE, fn, Wgu_t + (size_t)e * 2048 * DM, 1, ri, wmx + WMAX_GU + e * 2048, scr, lane); else convert_mat_item8(wg + (size_t)e * DM * DFE, DFE, DM, DFE, fn, Wgu_t + (size_t)e * 2048 * DM, 1, ri, scr, lane); }
            else if (kind == 1) { if (GU_MODE == 2) convert_mat_item_q8(wu + (size_t)e * DM * DFE, DFE, DM, DFE, fn, Wgu_t + (size_t)e * 2048 * DM, 2, ri, wmx + WMAX_GU + e * 2048, scr, lane); else convert_mat_item8(wu + (size_t)e * DM * DFE, DFE, DM, DFE, fn, Wgu_t + (size_t)e * 2048 * DM, 2, ri, scr, lane); }
            else convert_mat_item8(wd + (size_t)e * DFE * DM, DM, DFE, DM, nullptr, Wd_t + (size_t)e * DM * DFE, 0, ri, scr, lane);
        }
        const float* rw = a.router_w + (size_t)li * DM * NE;
        for (int e = gw * 64 + lane; e < 8 * DM; e += NGW * 64) { const int j = e / DM, k = e % DM; Wr_t[e] = (bf16_t)(cvtpk(rw[(size_t)k * NE + j] * fn[k], 0.f) & 0xffffu); }
    }
    for (int e = gw * 64 + lane; e < 8 * DM; e += NGW * 64) { const int j = e / DM, k = e % DM; Wf_t[e] = (bf16_t)(cvtpk(w_in[(size_t)k * P_IN + PROJ_N + j] * an[k], 0.f) & 0xffffu); }
}
template <bool HAS_GAIN>
DI void convert_strip_q8(const float* W, int ld, int n0, const float* gain, unsigned char* WT, int dst_row0, float* wmax_out, LAS unsigned char* ldsb, int tid) {
    constexpr int PITCH = 1025; LAS unsigned* st = (LAS unsigned*)ldsb; LAS unsigned* cmax = st + 32 * PITCH;
    asm volatile("" : "+v"(tid));
    __syncthreads();
    if (tid < 32) cmax[tid] = 0u;
    __syncthreads();
    {
      const int c4 = tid & 7, rg = tid >> 3; const float* wp = W + (size_t)n0 + 4 * c4; f32x4 m4 = {0.f, 0.f, 0.f, 0.f};
#pragma unroll
      for (int i0 = 0; i0 < 16; i0 += 8) {
          f32x4 v0[8], v1[8]; f32x2 gg[8];
#pragma unroll
          for (int i = 0; i < 8; ++i) { const int k = 2 * (64 * (i0 + i) + rg); v0[i] = *(const f32x4*)(wp + (size_t)k * ld); v1[i] = *(const f32x4*)(wp + (size_t)(k + 1) * ld);
              if (HAS_GAIN) gg[i] = *(const f32x2*)(gain + k); else gg[i] = (f32x2){1.0f, 1.0f}; }
#pragma unroll
          for (int i = 0; i < 8; ++i) { const f32x4 a0 = v0[i] * gg[i][0], a1 = v1[i] * gg[i][1];
#pragma unroll
              for (int j = 0; j < 4; ++j) { m4[j] = __builtin_fmaxf(m4[j], __builtin_fmaxf(__builtin_fabsf(a0[j]), __builtin_fabsf(a1[j]))); st[(4 * c4 + j) * PITCH + 64 * (i0 + i) + rg] = cvtpk(a0[j], a1[j]); } }
      }
#pragma unroll
      for (int j = 0; j < 4; ++j) __hip_atomic_fetch_max(cmax + 4 * c4 + j, __float_as_uint(m4[j]), __ATOMIC_RELAXED, __HIP_MEMORY_SCOPE_WORKGROUP); }
    __syncthreads();
    if (tid < 32) wmax_out[dst_row0 + tid] = __uint_as_float(cmax[tid]);
#pragma unroll
    for (int j = 0; j < 8; ++j) {
        const int q = tid + 512 * j; const int cr = (q & 15) | (((q >> 6) & 1) << 4), p = ((q >> 4) & 3) | ((q >> 7) << 2);
        const float sw = 127.0f / __builtin_fmaxf(__uint_as_float(cmax[cr]), 1e-30f);
        unsigned d[8];
#pragma unroll
        for (int e = 0; e < 8; ++e) d[e] = st[cr * PITCH + 8 * p + e];
        u32x4 o;
        o.x = pk4_q8(__uint_as_float(d[0] << 16) * sw, __uint_as_float(d[0] & 0xffff0000u) * sw, __uint_as_float(d[1] << 16) * sw, __uint_as_float(d[1] & 0xffff0000u) * sw);
        o.y = pk4_q8(__uint_as_float(d[2] << 16) * sw, __uint_as_float(d[2] & 0xffff0000u) * sw, __uint_as_float(d[3] << 16) * sw, __uint_as_float(d[3] & 0xffff0000u) * sw);
        o.z = pk4_q8(__uint_as_float(d[4] << 16) * sw, __uint_as_float(d[4] & 0xffff0000u) * sw, __uint_as_float(d[5] << 16) * sw, __uint_as_float(d[5] & 0xffff0000u) * sw);
        o.w = pk4_q8(__uint_as_float(d[6] << 16) * sw, __uint_as_float(d[6] & 0xffff0000u) * sw, __uint_as_float(d[7] << 16) * sw, __uint_as_float(d[7] & 0xffff0000u) * sw);
        *(u32x4*)(WT + (size_t)(dst_row0 + cr) * DM + 16 * p) = o;
    }
}
DI void convert_layer_sp(const Args& a, int l, LAS unsigned char* ldsb, int wave, int lane) {
    static_assert(G1_MODE == 2 && G2_MODE == 2 && GU_MODE == 2, "single-pass copies are the int8 configuration");
    unsigned char* slot = a.ws + WS_WBUF + (size_t)(l & 1) * WSLOT;
    unsigned char* Win_t = slot + WO_WIN; bf16_t* Wf_t = (bf16_t*)(slot + WO_WF); bf16_t* Wr_t = (bf16_t*)(slot + WO_WR); unsigned char* Wout_t = slot + WO_WOUT; unsigned char* Wgu_t = slot + WO_FFN_GU;
    const float* w_in = a.w_in + (size_t)l * DM * P_IN; const float* w_out = a.w_out + (size_t)l * DM * DM;
    const float* an = a.attn_norm + l * DM; const float* fn = a.ffn_norm + l * DM; const int li = l >> 1; const bool moe = (l & 1) != 0;
    float* wmx = (float*)(a.ws + WS_WMAX) + (size_t)l * WMAX_LAYER;
    const int G = gridDim.x, wg = blockIdx.x; int tid = wave * 64 + lane;
    constexpr int NS_IN = PROJ_N / 32, NS_OUT = DM / 32, NS_G = DFF / 32, NS_E = DFE / 32;
    const int NS = NS_IN + NS_OUT + (moe ? 2 * NE * NS_E : 2 * NS_G);
    const float* wg_d = a.dense_w_gate + (size_t)li * DM * DFF; const float* wu_d = a.dense_w_up + (size_t)li * DM * DFF;
    const float* wg_m = a.moe_w_gate + (size_t)li * NE * DM * DFE; const float* wu_m = a.moe_w_up + (size_t)li * NE * DM * DFE;
    for (int sidx = wg; sidx < NS; sidx += G) {
        int r = sidx;
        if (r < NS_IN) { convert_strip_q8<true>(w_in, P_IN, 32 * r, an, Win_t, 32 * r, wmx + WMAX_IN, ldsb, tid); continue; } r -= NS_IN;
        if (r < NS_OUT) { convert_strip_q8<false>(w_out, DM, 32 * r, nullptr, Wout_t, 32 * r, wmx + WMAX_OUT, ldsb, tid); continue; } r -= NS_OUT;
        if (!moe) { const int kind = r / NS_G, n0 = 32 * (r % NS_G); convert_strip_q8<true>(kind ? wu_d : wg_d, DFF, n0, fn, Wgu_t, dst_row_of(kind ? 2 : 1, n0), wmx + WMAX_GU, ldsb, tid); }
        else { const int kind = r / (NE * NS_E), e = (r / NS_E) % NE, n0 = 32 * (r % NS_E);
               convert_strip_q8<true>((kind ? wu_m : wg_m) + (size_t)e * DM * DFE, DFE, n0, fn, Wgu_t + (size_t)e * 2048 * DM, dst_row_of(kind ? 2 : 1, n0), wmx + WMAX_GU + e * 2048, ldsb, tid); }
    }
    __syncthreads();
    LAS float* scr = (LAS float*)(ldsb + wave * 16384);
    const int I = moe ? NE * (DFE / 64) * (DM / 32) : (DFF / 64) * (DM / 32);
    const int base = NS / G, rem = NS % G, tgt = (32 * NS + I + G - 1) / G;
    const int ihi = max(0, tgt - 32 * (base + 1)), ilo = max(0, tgt - 32 * base);
    const int start = wg < rem ? wg * ihi : rem * ihi + (wg - rem) * ilo; int end = start + (wg < rem ? ihi : ilo); if (wg == G - 1) end = I; if (end > I) end = I;
    if (!moe) { const float* wd = a.dense_w_down + (size_t)li * DFF * DM; unsigned char* Wd_t = slot + WO_DENSE_D;
        for (int it = start + wave; it < end; it += 8) convert_mat_item8(wd, DM, DFF, DM, nullptr, Wd_t, 0, it, scr, lane); }
    else { const float* wd = a.moe_w_down + (size_t)li * NE * DFE * DM; unsigned char* Wd_t = slot + WO_MOE_D; constexpr int I_E = (DFE / 64) * (DM / 32);
        for (int it = start + wave; it < end; it += 8) { const int e = it / I_E, ri = it % I_E; convert_mat_item8(wd + (size_t)e * DFE * DM, DM, DFE, DM, nullptr, Wd_t + (size_t)e * DM * DFE, 0, ri, scr, lane); }
        const float* rw = a.router_w + (size_t)li * DM * NE; const int gw = wg * 8 + wave, NGW = G * 8;
        for (int e = gw * 64 + lane; e < 8 * DM; e += NGW * 64) { const int j = e / DM, k = e % DM; Wr_t[e] = (bf16_t)(cvtpk(rw[(size_t)k * NE + j] * fn[k], 0.f) & 0xffffu); } }
    { const int gw = wg * 8 + wave, NGW = G * 8;
      for (int e = gw * 64 + lane; e < 8 * DM; e += NGW * 64) { const int j = e / DM, k = e % DM; Wf_t[e] = (bf16_t)(cvtpk(w_in[(size_t)k * P_IN + PROJ_N + j] * an[k], 0.f) & 0xffffu); } }
}
DI void prologue_rows(const Args& a, int gw, int NGW, int lane) {
    bf16_t* hb = (bf16_t*)(a.ws + WS_HB); u64* rowss = (u64*)(a.ws + WS_ROWSS); unsigned char* hb8 = a.ws + WS_HB8;
    for (int row = gw; row < MTOK; row += NGW) {
        const f32x4* xr = (const f32x4*)(a.x + (size_t)row * DM) + 2 * lane; u32x4* br = (u32x4*)(hb + (size_t)row * DM) + lane; u32x2* b8 = (u32x2*)(hb8 + (size_t)row * DM) + lane;
        f32x4 v[8]; float s = 0.f;
#pragma unroll
        for (int j = 0; j < 4; ++j) { v[2 * j] = xr[128 * j]; v[2 * j + 1] = xr[128 * j + 1]; }
#pragma unroll
        for (int j = 0; j < 8; ++j) s += (v[j][0] * v[j][0] + v[j][1] * v[j][1]) + (v[j][2] * v[j][2] + v[j][3] * v[j][3]);
        s = wave_sum(s);
        const u64 sfix = (u64)(s * RS_FIX); const float sa8 = rs_from(sfix) * (127.0f / Q8_R);
#pragma unroll
        for (int j = 0; j < 4; ++j) { u32x4 w; w.x = cvtpk(v[2 * j][0], v[2 * j][1]); w.y = cvtpk(v[2 * j][2], v[2 * j][3]); w.z = cvtpk(v[2 * j + 1][0], v[2 * j + 1][1]); w.w = cvtpk(v[2 * j + 1][2], v[2 * j + 1][3]); br[64 * j] = w; if (G1_MODE == 2) b8[64 * j] = pg8::q8x8(w, sa8); }
        if (lane == 0) rowss[row] = sfix;
    }
}
DI void final_rows(const Args& a, int gw, int NGW, int lane) {
    const u64* rowss = (const u64*)(a.ws + WS_ROWSS) + (size_t)8 * MTOK; const bf16_t* hb = (const bf16_t*)(a.ws + WS_HB);
    f32x4 g[8];
#pragma unroll
    for (int j = 0; j < 4; ++j) { g[2 * j] = *((const f32x4*)a.final_norm + 2 * lane + 128 * j); g[2 * j + 1] = *((const f32x4*)a.final_norm + 2 * lane + 128 * j + 1); }
    for (int row = gw; row < MTOK; row += 2 * NGW) {
        const int row2 = row + NGW < MTOK ? row + NGW : row;
        const u32x4* br = (const u32x4*)(hb + (size_t)row * DM) + lane; const u32x4* br2 = (const u32x4*)(hb + (size_t)row2 * DM) + lane;
        const u64 r1 = rowss[row], r2 = rowss[row2];
        u32x4 w1[4], w2[4];
#pragma unroll
        for (int j = 0; j < 4; ++j) { w1[j] = br[64 * j]; w2[j] = br2[64 * j]; }
#pragma unroll
        for (int h = 0; h < 2; ++h) {
            if (h == 1 && row2 == row) break;
            f32x4* orow = (f32x4*)(a.out + (size_t)(h ? row2 : row) * DM) + 2 * lane; const float rs = rs_from(h ? r2 : r1);
#pragma unroll
            for (int j = 0; j < 4; ++j) { const u32x4 w = h ? w2[j] : w1[j];
                f32x4 v0 = { __uint_as_float(w.x << 16), __uint_as_float(w.x & 0xffff0000u), __uint_as_float(w.y << 16), __uint_as_float(w.y & 0xffff0000u) };
                f32x4 v1 = { __uint_as_float(w.z << 16), __uint_as_float(w.z & 0xffff0000u), __uint_as_float(w.w << 16), __uint_as_float(w.w & 0xffff0000u) };
                orow[128 * j] = v0 * rs * g[2 * j]; orow[128 * j + 1] = v1 * rs * g[2 * j + 1]; }
        }
    }
}
DI f32x4 skinny16(const bf16_t* hb, const bf16_t* Wt, int row0, int lane) {
    const int n = lane & 15, q = lane >> 4;
    const bf16_t* ap = hb + (size_t)(row0 + n) * DM + 512 * q; const bf16_t* bp = Wt + (size_t)(n & 7) * DM + 512 * q;
    f32x4 acc = {0.f, 0.f, 0.f, 0.f};
    for (int it = 0; it < 8; ++it) {
        bf16x8 av[8], bv[8];
#pragma unroll
        for (int u = 0; u < 8; ++u) { av[u] = *(const bf16x8*)(ap + it * 64 + u * 8); bv[u] = *(const bf16x8*)(bp + it * 64 + u * 8); }
#pragma unroll
        for (int u = 0; u < 8; ++u) { if (n >= 8) bv[u] = (bf16x8){0, 0, 0, 0, 0, 0, 0, 0}; acc = __builtin_amdgcn_mfma_f32_16x16x32_bf16(av[u], bv[u], acc, 0, 0, 0); }
    }
    return acc;
}
DI float nl_of(float dot, float rs, float bias) { const float x2 = (dot * rs + bias) * LOG2E; return fmaxf(-x2, 0.f) + fast_log2(1.0f + fast_exp2(-fabsf(x2))); }
DI void logf_rows(const Args& a, int l, int gw, int NGW, int lane) {
    const bf16_t* hb = (const bf16_t*)(a.ws + WS_HB); const bf16_t* Wf_t = (const bf16_t*)(a.ws + WS_WBUF + (size_t)(l & 1) * WSLOT + WO_WF);
    float* logf = (float*)(a.ws + WS_LOGF); const u64* rowss = (const u64*)(a.ws + WS_ROWSS) + (size_t)(2 * l) * MTOK;
    const int n = lane & 15, q = lane >> 4; const float bias = a.b_forget[l * 8 + (n & 7)];
    for (int grp = gw; grp < MTOK / 16; grp += NGW) {
        const f32x4 acc = skinny16(hb, Wf_t, grp * 16, lane);
        if (n < 8) {
#pragma unroll
            for (int j = 0; j < 4; ++j) { const int row = grp * 16 + 4 * q + j; logf[(size_t)row * 8 + n] = nl_of(acc[j], rs_from(rowss[row]), bias); }
        }
    }
}
DI void nl_rows(const Args& a, int l, int gw, int NGW, int lane) {
    const int* xacc = (const int*)(a.ws + WS_XACC) + (size_t)l * XSLOT; float* logf = (float*)(a.ws + WS_LOGF); const u64* rowss = (const u64*)(a.ws + WS_ROWSS) + (size_t)(2 * l) * MTOK;
    for (int e = gw * 64 + lane; e < MTOK * 8; e += NGW * 64) {
        int v[8];
#pragma unroll
        for (int p = 0; p < 8; ++p) v[p] = xacc[(size_t)p * XPLANE + e];
        const u64 rsv = rowss[e >> 3]; const float bias = a.b_forget[l * 8 + (e & 7)];
        const int sum = ((v[0] + v[1]) + (v[2] + v[3])) + ((v[4] + v[5]) + (v[6] + v[7]));
        logf[e] = nl_of((float)sum * (1.0f / XFIX), rs_from(rsv), bias);
    }
}
DI void router_rows(const Args& a, int l, LAS unsigned char* ldsb, int wave, int lane) {
    const int* racc = (const int*)(a.ws + WS_XACC) + (size_t)(4 + (l >> 1)) * XSLOT;
    const u64* rowss = (const u64*)(a.ws + WS_ROWSS) + (size_t)(2 * l + 1) * MTOK;
    unsigned* gcnt = (unsigned*)(a.ws + WS_CTL) + CW_MOECNT + (l >> 1) * 16 * 64;
    int* tokl = (int*)(a.ws + WS_TOK); float* gatel = (float*)(a.ws + WS_GATE); float* rsl = (float*)(a.ws + WS_RSL); const u64* rowss_q = (const u64*)(a.ws + WS_ROWSS) + (size_t)(2 * l) * MTOK;
    volatile LAS unsigned* lcnt = (volatile LAS unsigned*)(ldsb + LCTL_OFF) + LC_RT;
    volatile LAS unsigned* lcnt2 = (volatile LAS unsigned*)(ldsb + LCTL_OFF) + LC_RT2;
    unsigned* gcnt2 = (unsigned*)(a.ws + WS_CTL) + CW_PAIRCNT + (l >> 1) * 32 * 64; int* ptok = (int*)(a.ws + WS_PTOK); int* prefA = (int*)(a.ws + WS_PREFA); int* prefB = (int*)(a.ws + WS_PREFB);
    const int tid = wave * 64 + lane;
    for (int g0 = blockIdx.x * 8; g0 < MTOK / 16; g0 += gridDim.x * 8) {
        const int grp = g0 + wave;
        if (tid < 16) lcnt[tid] = 0u;
        if (tid < 32) lcnt2[tid] = 0u;
        __syncthreads();
        int e0 = 0, e1 = 1; float gt0 = 0.f, gt1 = 0.f, rsc = 0.f; unsigned p0 = 0u, p1 = 0u, pp = 0u; int pid = 0; const int row = grp * 16 + lane;
        const bool act = grp < MTOK / 16;
        if (act) {
            if (lane < 16) {
                float v[8]; const float rs1 = rs_from(rowss[row]); const float rsr = rs1 * (1.0f / XFIX); const int* xr = racc + (size_t)row * 8; rsc = rs1 * (Q8_R / 127.0f) / rs_from(rowss_q[row]);
                i32x4 s0 = {0, 0, 0, 0}, s1 = {0, 0, 0, 0};
#pragma unroll
                for (int p = 0; p < 8; ++p) { s0 += *(const i32x4*)(xr + p * XPLANE); s1 += *(const i32x4*)(xr + p * XPLANE + 4); }
#pragma unroll
                for (int k = 0; k < 4; ++k) { v[k] = (float)s0[k] * rsr; v[4 + k] = (float)s1[k] * rsr; }
                float b0 = v[0]; e0 = 0;
#pragma unroll
                for (int k = 1; k < 8; ++k) if (v[k] > b0) { b0 = v[k]; e0 = k; }
                float b1 = -INFINITY; e1 = 0;
#pragma unroll
                for (int k = 0; k < 8; ++k) if (k != e0 && v[k] > b1) { b1 = v[k]; e1 = k; }
                const float ex = fast_exp2((b1 - b0) * LOG2E); gt0 = fast_rcp(1.0f + ex); gt1 = ex * gt0;
                p0 = __hip_atomic_fetch_add((LAS unsigned*)&lcnt[e0], 1u, __ATOMIC_RELAXED, __HIP_MEMORY_SCOPE_WORKGROUP);
                p1 = __hip_atomic_fetch_add((LAS unsigned*)&lcnt[8 + e1], 1u, __ATOMIC_RELAXED, __HIP_MEMORY_SCOPE_WORKGROUP);
                pid = pair_id(min(e0, e1), max(e0, e1)); pp = __hip_atomic_fetch_add((LAS unsigned*)&lcnt2[pid], 1u, __ATOMIC_RELAXED, __HIP_MEMORY_SCOPE_WORKGROUP);
            }
        }
        __syncthreads();
        if (tid < 16) { const unsigned c = lcnt[tid]; lcnt[16 + tid] = c ? __hip_atomic_fetch_add(gcnt + 64 * tid, c, __ATOMIC_RELAXED, __HIP_MEMORY_SCOPE_AGENT) : 0u; }
        if (tid >= 64 && tid < 64 + NPAIR) { const int j = tid - 64; const unsigned c = lcnt2[j]; lcnt2[32 + j] = c ? __hip_atomic_fetch_add(gcnt2 + 64 * j, c, __ATOMIC_RELAXED, __HIP_MEMORY_SCOPE_AGENT) : 0u; }
        __syncthreads();
        if (act && lane < 16) {
            const unsigned q0 = lcnt[16 + e0] + p0, q1 = lcnt[16 + 8 + e1] + p1;
            tokl[(size_t)e0 * MTOK + q0] = row; gatel[(size_t)e0 * MTOK + q0] = gt0; rsl[(size_t)e0 * MTOK + q0] = rsc;
            tokl[(size_t)(8 + e1) * MTOK + q1] = row; gatel[(size_t)(8 + e1) * MTOK + q1] = gt1; rsl[(size_t)(8 + e1) * MTOK + q1] = rsc;
            { const unsigned qp = lcnt2[32 + pid] + pp; const int r0_ = e0 * MTOK + (int)q0, r1_ = (8 + e1) * MTOK + (int)q1;
              ptok[(size_t)pid * MTOK + qp] = row; prefA[(size_t)pid * MTOK + qp] = e0 < e1 ? r0_ : r1_; prefB[(size_t)pid * MTOK + qp] = e0 < e1 ? r1_ : r0_; }
        }
        __syncthreads();
    }
}
DI void moe_tables(const Args& a, int l, LAS unsigned char* ldsb, int c0, int nc) {
    LAS int* tab = (LAS int*)(ldsb + LCTL_OFF) + LC_MOE;
    const unsigned* gcnt = (const unsigned*)(a.ws + WS_CTL) + CW_MOECNT + (l >> 1) * 16 * 64;
    __syncthreads();
    if (threadIdx.x == 0) {
        int pt = 0;
        for (int c = 0; c < 16; ++c) { const int n = (int)gcnt[64 * c]; tab[c] = n; tab[33 + c] = pt; pt += (n + 255) >> 8; }
        int tp = 0;
        for (int j = 0; j < nc; ++j) { tab[16 + j] = tp; tp += (tab[c0 + j] + 255) >> 8; }
        tab[16 + nc] = tp;
    }
    __syncthreads();
}

DI void moe_tables_pair(const Args& a, int l, LAS unsigned char* ldsb) {
    moe_tables(a, l, ldsb, 0, 16);
    LAS int* tab2 = (LAS int*)(ldsb + LCTL_OFF) + LC_PAIR;
    const unsigned* gcnt2 = (const unsigned*)(a.ws + WS_CTL) + CW_PAIRCNT + (l >> 1) * 32 * 64;
    if (threadIdx.x == 0) { int tp = 0;
        for (int j = 0; j < NPAIR; ++j) { const int n = (int)gcnt2[64 * j]; tab2[j] = n; tab2[32 + j] = tp; tp += (n + 255) >> 8; }
        tab2[32 + NPAIR] = tp; }
    __syncthreads();
}

namespace att {
DI int crow(int i, int h) { return (i & 3) + 8 * (i >> 2) + 4 * h; }
DI float swap_add(float v) { auto rr = __builtin_amdgcn_permlane32_swap(__float_as_uint(v), __float_as_uint(v), false, false); return __uint_as_float(rr[0]) + __uint_as_float(rr[1]); }
DI float swap_max(float v) { auto rr = __builtin_amdgcn_permlane32_swap(__float_as_uint(v), __float_as_uint(v), false, false); return fmaxf(__uint_as_float(rr[0]), __uint_as_float(rr[1])); }
DI s16x4 vtr(const LAS unsigned char* p) { return __builtin_bit_cast(s16x4, __builtin_amdgcn_ds_read_tr16_b64_v4i16((LAS s16x4*)p)); }
DI bf16x8 pack8(const float* w) { u32x4 p; p.x = cvtpk(w[0], w[1]); p.y = cvtpk(w[2], w[3]); p.z = cvtpk(w[4], w[5]); p.w = cvtpk(w[6], w[7]); return __builtin_bit_cast(bf16x8, p); }
#define ATT_VMWAIT(n) asm volatile("s_waitcnt vmcnt(" #n ")" ::: "memory")
#define ATT_LGKMWAIT() asm volatile("s_waitcnt lgkmcnt(0)" ::: "memory")
DI void dma_offsets(unsigned (&doff)[8], int lane) {
    const int lr = lane >> 4, p = lane & 15;
#pragma unroll
    for (int i = 0; i < 8; ++i) { const int row = 4 * i + lr; doff[i] = (unsigned)(row * (PROJ_N * 2) + ((p ^ (row & 15)) << 4)); }
}
DI void dma_tile(const bf16_t* src  , LAS unsigned char* dst, const unsigned (&doff)[8]) {
#pragma unroll
    for (int i = 0; i < 8; ++i) __builtin_amdgcn_global_load_lds((const unsigned*)((const char*)src + doff[i]), (LAS unsigned*)(dst + i * 1024), 16, 0, 0);
}

template <int TYPE>
DI void wave_unit(LAS unsigned char* wl, const bf16_t* proj, bf16_t* mix, const float* ssq, const float* logf, const float* gout, int b, int head, int q0, float B2T, int lane) {
    asm volatile("" : "+v"(lane));
    const int r = lane & 31, h = lane >> 5;
    const int qcol = (TYPE ? 3072 : 0) + head * HD, kcol = (TYPE ? 4096 : 1024) + head * HD, vcol = (TYPE ? 5120 : 2048) + head * HD;
    const size_t rowg = (size_t)b * SEQ + q0 + r;
    LAS unsigned char* Kl = wl; LAS unsigned char* Vl = wl + 8192; LAS float* scr = (LAS float*)(wl + 16384);
    const bf16_t* kbase = proj + (size_t)b * SEQ * PROJ_N + kcol; const bf16_t* vbase = proj + (size_t)b * SEQ * PROJ_N + vcol;
    unsigned doff[8]; dma_offsets(doff, lane);
    dma_tile(kbase + (size_t)q0 * PROJ_N, Kl, doff);
    dma_tile(vbase + (size_t)q0 * PROJ_N, Vl, doff);
    float rkv = 0.f, nl = 0.f;
    f32x4 spk = {0.f, 0.f, 0.f, 0.f}, spq = {0.f, 0.f, 0.f, 0.f};
    if (TYPE) { const size_t krow = (size_t)b * SEQ + q0 + (lane & 31); spk = *(const f32x4*)(ssq + (krow * 16 + 8 + head) * 4); nl = logf[krow * 8 + head]; }
    bf16x8 qf[8];
    { const bf16_t* qp = proj + rowg * PROJ_N + qcol + 8 * h;
#pragma unroll
      for (int ds = 0; ds < 8; ++ds) qf[ds] = *(const bf16x8*)(qp + 16 * ds); }
    if (TYPE) spq = *(const f32x4*)(ssq + (rowg * 16 + head) * 4);
    asm volatile("" ::: "memory");
    if (TYPE) rkv = __builtin_amdgcn_rsqf(((spk[0] + spk[1]) + (spk[2] + spk[3])) * (1.0f / HD) + NORM_EPS);
    if (TYPE) {
        const f32x4 sp = spq;
        const float rq = __builtin_amdgcn_rsqf(((sp[0] + sp[1]) + (sp[2] + sp[3])) * (1.0f / HD) + NORM_EPS) * QK_SCALE2;
#pragma unroll
        for (int ds = 0; ds < 8; ++ds) { float f[8];
#pragma unroll
            for (int j = 0; j < 8; ++j) f[j] = bf2f((unsigned short)qf[ds][j]) * rq;
            qf[ds] = pack8(f); }
    }
    f32x16 O[4];
#pragma unroll
    for (int d = 0; d < 4; ++d)
#pragma unroll
        for (int i = 0; i < 16; ++i) O[d][i] = 0.f;
    float after = 0.f;
    float mrow = -INFINITY, lrow = 0.f, carry = 0.f;
    const LAS unsigned char* krow_p = Kl + r * 256; const int kx = r & 15;
    const int tq = (lane & 15) >> 2, tp = lane & 3, tblk = (lane >> 4) & 1;
    const LAS unsigned char* vrow_p = Vl + (4 * h + tq) * 256 + 8 * (tp & 1); const int vx = 4 * h + tq, vc0 = 2 * tblk + (tp >> 1);
    for (int kt = q0 >> 5; kt >= 0; --kt) {
        const int s0 = kt * 32; const bool diag = (s0 == q0);
        if (TYPE) {
            float sfx = nl;
#pragma unroll
            for (int o = 1; o < 32; o <<= 1) { const float t = __shfl_down(sfx, o); if ((lane & 31) + o < 32) sfx += t; }
            const float tot = __shfl(sfx, 0);
            if (lane < 32) { scr[lane] = carry + (sfx - nl); scr[32 + lane] = rkv; }
            carry += tot;
        }
        f32x4 sp_n = {0.f, 0.f, 0.f, 0.f}; float nl_n = 0.f;
        if (TYPE) { const size_t krow = (size_t)b * SEQ + (s0 >= 32 ? s0 - 32 : 0) + (lane & 31); sp_n = *(const f32x4*)(ssq + (krow * 16 + 8 + head) * 4); nl_n = logf[krow * 8 + head]; }
        if (TYPE) ATT_VMWAIT(10); else ATT_VMWAIT(8);
        f32x16 x;
#pragma unroll
        for (int i = 0; i < 16; ++i) x[i] = 0.f;
#pragma unroll
        for (int ds = 0; ds < 8; ++ds) { const bf16x8 kf = *(const LAS bf16x8*)(krow_p + (((2 * ds + h) ^ kx) << 4)); x = __builtin_amdgcn_mfma_f32_32x32x16_bf16(kf, qf[ds], x, 0, 0, 0); }
        ATT_LGKMWAIT();
        if (kt > 0) dma_tile(kbase + (size_t)(s0 - 32) * PROJ_N, Kl, doff);
        float w[16]; bool negl = false;
        if (TYPE == 0) {
            float sp[16];
#pragma unroll
            for (int i = 0; i < 16; ++i) { const bool valid = !diag || (crow(i, h) < r); const float xi = x[i];
                const float s2 = fmaxf(xi, 0.f) + fast_log2(1.0f + fast_exp2(-fabsf(xi))); sp[i] = valid ? s2 : 0.f; }
            float U = after;
#pragma unroll
            for (int g = 3; g >= 0; --g) {
                const float s3 = sp[4 * g + 3], s2 = sp[4 * g + 2] + s3, s1 = sp[4 * g + 1] + s2, s0v = sp[4 * g] + s1;
                const float T = swap_add(s0v);
                const float base = U + (h == 0 ? T - s0v : 0.f);
                const float sv[4] = {s0v, s1, s2, s3};
#pragma unroll
                for (int k = 0; k < 4; ++k) { const int i = 4 * g + k; const bool valid = !diag || (crow(i, h) < r); w[i] = valid ? fast_exp2(x[i] - (base + sv[k])) : 0.f; }
                U += T;
            }
            after = U;
        } else {
            f32x4 d2v[4], rk4[4];
#pragma unroll
            for (int g = 0; g < 4; ++g) { d2v[g] = *(const LAS f32x4*)(scr + 8 * g + 4 * h); rk4[g] = *(const LAS f32x4*)(scr + 32 + 8 * g + 4 * h); }
            float tmax = -INFINITY;
#pragma unroll
            for (int i = 0; i < 16; ++i) { const bool valid = !diag || (crow(i, h) <= r); float lgt = x[i] * rk4[i >> 2][i & 3] - d2v[i >> 2][i & 3]; lgt = valid ? lgt : -INFINITY; w[i] = lgt; tmax = fmaxf(tmax, lgt); }
            tmax = swap_max(tmax);
            negl = __all(tmax < mrow - 30.0f);
            if (!negl) {
            const float mnew = fmaxf(mrow, tmax); const float alpha = fast_exp2(mrow - mnew); mrow = mnew;
            float ps = 0.f;
#pragma unroll
            for (int i = 0; i < 16; ++i) { w[i] = fast_exp2(w[i] - mnew); ps += w[i]; }
            lrow = lrow * alpha + ps;
            if (!__all(alpha == 1.0f)) {
#pragma unroll
                for (int d = 0; d < 4; ++d)
#pragma unroll
                    for (int i = 0; i < 16; ++i) O[d][i] *= alpha;
            }
            }
        }
        const bf16x8 pf0 = pack8(w), pf1 = pack8(w + 8);
        if (kt > 0) ATT_VMWAIT(8); else ATT_VMWAIT(0);
        if (!negl) {
#pragma unroll
        for (int db = 0; db < 4; ++db) {
            const int cc = 4 * db + vc0;
            const s16x4 a0 = vtr(vrow_p + ((cc ^ vx) << 4)), a1 = vtr(vrow_p + 8 * 256 + ((cc ^ vx ^ 8) << 4)), c0 = vtr(vrow_p + 16 * 256 + ((cc ^ vx) << 4)), c1 = vtr(vrow_p + 24 * 256 + ((cc ^ vx ^ 8) << 4));
            const bf16x8 v0 = __builtin_shufflevector(a0, a1, 0, 1, 2, 3, 4, 5, 6, 7), v1 = __builtin_shufflevector(c0, c1, 0, 1, 2, 3, 4, 5, 6, 7);
            O[db] = __builtin_amdgcn_mfma_f32_32x32x16_bf16(v0, pf0, O[db], 0, 0, 0);
            O[db] = __builtin_amdgcn_mfma_f32_32x32x16_bf16(v1, pf1, O[db], 0, 0, 0);
        }
        }
        if (TYPE) { asm volatile("" : "+v"(nl_n), "+v"(sp_n));
            rkv = __builtin_amdgcn_rsqf(((sp_n[0] + sp_n[1]) + (sp_n[2] + sp_n[3])) * (1.0f / HD) + NORM_EPS); nl = nl_n; }
        if (TYPE == 0) { if (__all(after >= SB_EXIT2)) break; }
        else { if (__all(mrow + carry >= B2T)) break; }
        if (kt > 0) { ATT_LGKMWAIT(); dma_tile(vbase + (size_t)(s0 - 32) * PROJ_N, Vl, doff); }
    }
    f32x4 gnv[4][4];
#pragma unroll
    for (int d = 0; d < 4; ++d)
#pragma unroll
        for (int g = 0; g < 4; ++g) gnv[d][g] = *(const f32x4*)(gout + head * HD + 32 * d + 8 * g + 4 * h);
    u32x4 gtv[8];
    if (TYPE) { const int lr = lane >> 4, p = lane & 15; const bf16_t* gp = proj + ((size_t)b * SEQ + q0) * PROJ_N + 6144 + head * HD;
#pragma unroll
        for (int i = 0; i < 8; ++i) { const int row = 4 * i + lr; const int c = p ^ (row & 15); gtv[i] = *(const u32x4*)(gp + (size_t)row * PROJ_N + c * 8); } }
    asm volatile("" ::: "memory");
    float scale = 1.0f;
    if (TYPE) scale = fast_rcp(swap_add(lrow));
    float ss = 0.f;
#pragma unroll
    for (int d = 0; d < 4; ++d)
#pragma unroll
        for (int i = 0; i < 16; ++i) { O[d][i] *= scale; ss += O[d][i] * O[d][i]; }
    ss = swap_add(ss);
    const float rinv = __builtin_amdgcn_rsqf(ss * (1.0f / HD) + NORM_EPS);
    ATT_LGKMWAIT();
#pragma unroll
    for (int d = 0; d < 4; ++d)
#pragma unroll
        for (int g = 0; g < 4; ++g) {
            const f32x4 gn = gnv[d][g];
            u32x2 o; o.x = cvtpk(O[d][4 * g] * rinv * gn[0], O[d][4 * g + 1] * rinv * gn[1]); o.y = cvtpk(O[d][4 * g + 2] * rinv * gn[2], O[d][4 * g + 3] * rinv * gn[3]);
            *(LAS u32x2*)(Vl + r * 256 + (((4 * d + g) ^ (r & 15)) << 4) + 8 * h) = o;
        }
    ATT_LGKMWAIT();
    { const int lr = lane >> 4, p = lane & 15;
      bf16_t* op = mix + ((size_t)b * SEQ + q0) * DM + (TYPE ? 1024 : 0) + head * HD;
#pragma unroll
      for (int i = 0; i < 8; ++i) { const int row = 4 * i + lr; const int c = p ^ (row & 15);
          u32x4 y = *(const LAS u32x4*)(Vl + row * 256 + p * 16);
          if (TYPE) { const u32x4 gt = gtv[i];
              y.x = cvtpk(__uint_as_float(y.x << 16) * __uint_as_float(gt.x << 16), __uint_as_float(y.x & 0xffff0000u) * __uint_as_float(gt.x & 0xffff0000u));
              y.y = cvtpk(__uint_as_float(y.y << 16) * __uint_as_float(gt.y << 16), __uint_as_float(y.y & 0xffff0000u) * __uint_as_float(gt.y & 0xffff0000u));
              y.z = cvtpk(__uint_as_float(y.z << 16) * __uint_as_float(gt.z << 16), __uint_as_float(y.z & 0xffff0000u) * __uint_as_float(gt.z & 0xffff0000u));
              y.w = cvtpk(__uint_as_float(y.w << 16) * __uint_as_float(gt.w << 16), __uint_as_float(y.w & 0xffff0000u) * __uint_as_float(gt.w & 0xffff0000u)); }
          if (G2_MODE == 2) *(u32x2*)((unsigned char*)mix + ((size_t)b * SEQ + q0 + row) * DM + (TYPE ? 1024 : 0) + head * HD + c * 8) = pg8::q8x8(y, 127.0f / MIX_R);
          else *(u32x4*)(op + (size_t)row * DM + c * 8) = y; }
    }
    ATT_LGKMWAIT();
}
#undef ATT_VMWAIT
#undef ATT_LGKMWAIT
}

DI void attention_phase(const Args& a, int l, LAS unsigned char* ldsb, int wave, int lane) {
    const bf16_t* proj = (const bf16_t*)(a.ws + WS_PROJ); bf16_t* mix = (bf16_t*)(a.ws + WS_MIX);
    const float* ssq = (const float*)(a.ws + WS_SSQ); const float* logf = (const float*)(a.ws + WS_LOGF);
    float gqm = fmaxf(fabsf(a.fox_q_norm[l * HD + lane]), fabsf(a.fox_q_norm[l * HD + 64 + lane])), gkm = fmaxf(fabsf(a.fox_k_norm[l * HD + lane]), fabsf(a.fox_k_norm[l * HD + 64 + lane]));
    gqm = wave_max(gqm); gkm = wave_max(gkm);
    const float B2T = 1.02f * 128.0f * QK_SCALE2 * gqm * gkm + FOX_EXIT2;
    LAS unsigned char* wl = ldsb + wave * ATT_WAVE_BYTES;
    const int G = gridDim.x;
    for (int i = 0;; ++i) {
        const int Uc = i * G + blockIdx.x; if (Uc >= 2048) break;
        const int type = (Uc + i) & 1, idx = Uc >> 1, head = (idx + i) & 7, b = (idx >> 3) & 1, qb = idx >> 4;
        const int q0 = qb * 256 + wave * 32;
        if (type == 0) att::wave_unit<0>(wl, proj, mix, ssq, logf, a.sb_out_norm + l * 1024, b, head, q0, B2T, lane);
        else att::wave_unit<1>(wl, proj, mix, ssq, logf, a.fox_out_norm + l * 1024, b, head, q0, B2T, lane);
    }
}

#ifndef PH_MASK
#define PH_MASK 0xFFFF
#endif
#define PH(k) ((PH_MASK >> (k)) & 1)
#ifndef REP_MASK
#define REP_MASK 0
#endif
#define NREP(k) (((REP_MASK >> (k)) & 1) ? 2 : 1)
#define MARK(k) ([]() { asm volatile("; PHASE_MARK " #k); return true; }())
constexpr int NSTEP = 35;
__global__ void __launch_bounds__(512, 2) fwd(Args a_unused) {
    extern __shared__ __attribute__((aligned(16))) unsigned char lds_raw[];
    LAS unsigned char* ldsb = (LAS unsigned char*)lds_raw;
    const int tid0 = threadIdx.x;
    volatile LAS unsigned* lctl = (volatile LAS unsigned*)(ldsb + LCTL_OFF);
    for (int u = tid0; u < (LDS_BYTES - LCTL_OFF) / 4; u += 512) lctl[u] = 0u;
    __syncthreads();
    int lo, hi; XcdBarrier bar;
    { const Args a = args_here(); lo = a.lo; hi = a.hi; unsigned* ctl = (unsigned*)(a.ws + WS_CTL);
      bar.bar = ctl + CW_BAR; bar.x = 0; bar.st = lctl + LC_BAR;
      if (hi - lo > 1) bar = xcd_barrier_post(ctl + CW_BAR, lctl + LC_BAR); }
#define IN(k) (lo <= (k) && (k) < hi)
#define SEAM(k) do { if ((k) + 1 < hi) xcd_barrier(bar); } while (0)
#define PHASE_VARS const Args a = args_here(); const int tid = opaque_tid(), lane = tid & 63, wave = __builtin_amdgcn_readfirstlane(tid >> 6); (void)lane; const int G = gridDim.x, gw = blockIdx.x * 8 + wave, NGW = G * 8; unsigned char* ws = a.ws; float* h = a.out; bf16_t* hb = (bf16_t*)(ws + WS_HB); \
    bf16_t* proj = (bf16_t*)(ws + WS_PROJ); bf16_t* mix = (bf16_t*)(ws + WS_MIX); u64* rowss = (u64*)(ws + WS_ROWSS); (void)G; (void)gw; (void)NGW; (void)h; (void)hb; (void)proj; (void)mix; (void)rowss;

    if (PH(0) && MARK(0) && IN(1)) {
        PHASE_VARS
_Pragma("nounroll") for (int rep = 0; rep < NREP(0); ++rep) {
        convert_layer_sp(a, 0, ldsb, wave, lane); __syncthreads();
        prologue_rows(a, gw, NGW, lane); }
        SEAM(1);
    }
    for (int l = 0; l < NLAYER; ++l) {
        const int sb = 2 + 8 * l;
        if (PH(1) && MARK(1) && IN(sb)) {
            PHASE_VARS
            unsigned char* slot = ws + WS_WBUF + (size_t)(l & 1) * WSLOT;
            if (l == 0) logf_rows(a, 0, gw, NGW, lane); else nl_rows(a, l, gw, NGW, lane);
            pg8::DenseSched S{G1_MODE == 2 ? (const char*)(ws + WS_HB8) : (const char*)hb, (const char*)(slot + WO_WIN), MTOK / 256, PROJ_N / 256, G, (int)blockIdx.x, (size_t)256 * DM * (G1_MODE == 2 ? 1 : 2)};
            pg8::EpiProj<G1_MODE> E{proj, rowss + (size_t)(2 * l) * MTOK, (float*)(ws + WS_SSQ), a.fox_q_norm + l * HD, a.fox_k_norm + l * HD,
                                    rowss + (size_t)(l == 0 ? 0 : 2 * l - 1) * MTOK, (const float*)(ws + WS_WMAX) + (size_t)l * WMAX_LAYER + WMAX_IN};
            __syncthreads();
_Pragma("nounroll") for (int rep = 0; rep < NREP(1); ++rep) pg8::gemm_phase<pg8::EpiProj<G1_MODE>, pg8::DenseSched, G1_MODE>(ldsb, DM * (G1_MODE == 2 ? 1 : 2), S, E);
            SEAM(sb);
        }
        if (PH(2) && MARK(2) && IN(sb + 1)) {
            if (l + 1 < NLAYER) { PHASE_VARS convert_layer_sp(a, l + 1, ldsb, wave, lane); __syncthreads(); }
_Pragma("nounroll") for (int rep = 0; rep < NREP(2); ++rep) { PHASE_VARS attention_phase(a, l, ldsb, wave, lane); }
            SEAM(sb + 1);
        }
        if (PH(3) && MARK(3) && IN(sb + 2)) {
            PHASE_VARS
            unsigned char* slot = ws + WS_WBUF + (size_t)(l & 1) * WSLOT;
            pg8::DenseSched S{(const char*)mix, (const char*)(slot + WO_WOUT), MTOK / 256, DM / 256, G, (int)blockIdx.x, (size_t)256 * DM * (G2_MODE == 2 ? 1 : 2)};
            pg8::EpiResid<true, G2_MODE> E{hb, rowss + (size_t)(2 * l + 1) * MTOK, ws + WS_HB8, G2_MODE == 2 ? MIX_R / 127.0f : 1.0f, rowss + (size_t)(2 * l) * MTOK, (const float*)(ws + WS_WMAX) + (size_t)l * WMAX_LAYER + WMAX_OUT,
                                              (l & 1) ? (int*)(ws + WS_XACC) + (size_t)(4 + (l >> 1)) * XSLOT : nullptr, (const bf16_t*)(slot + WO_WR), (LAS int*)(ldsb + XLDS_OFF)};
            { LAS int* xz = (LAS int*)(ldsb + XLDS_OFF); for (int i = tid; i < 2048; i += 512) xz[i] = 0; __syncthreads(); }
            pg8::gemm_phase<pg8::EpiResid<true, G2_MODE>, pg8::DenseSched, G2_MODE>(ldsb, DM * (G2_MODE == 2 ? 1 : 2), S, E);
            SEAM(sb + 2);
        }
        if ((l & 1) == 0) {
            if (PH(4) && MARK(4) && IN(sb + 3)) {
                PHASE_VARS
                unsigned char* slot = ws + WS_WBUF + (size_t)(l & 1) * WSLOT;
                if (DENSE_IS_F8(l)) {
                pg8::DenseSched S{(const char*)(ws + WS_HB8), (const char*)(slot + WO_FFN_GU), MTOK / 256, 2 * DFF / 256, G, (int)blockIdx.x, (size_t)256 * DM};
                pg8::EpiSwiglu<false, GU_MODE> E{(unsigned char*)proj, DFF, rowss + (size_t)(2 * l + 1) * MTOK, nullptr, rowss + (size_t)(2 * l) * MTOK, (const float*)(ws + WS_WMAX) + (size_t)l * WMAX_LAYER + WMAX_GU};
_Pragma("nounroll") for (int rep = 0; rep < NREP(4); ++rep) pg8::gemm_phase<pg8::EpiSwiglu<false, GU_MODE>, pg8::DenseSched, GU_MODE>(ldsb, DM, S, E);
                } else {
                pg8::DenseSched S{(const char*)hb, (const char*)(slot + WO_FFN_GU), MTOK / 256, 2 * DFF / 256, G, (int)blockIdx.x, (size_t)256 * DM * 2};
                pg8::EpiSwiglu<false, 0> E{(unsigned char*)proj, DFF, rowss + (size_t)(2 * l + 1) * MTOK, nullptr, nullptr, nullptr};
_Pragma("nounroll") for (int rep = 0; rep < NREP(4); ++rep) pg8::gemm_phase<pg8::EpiSwiglu<false, 0>, pg8::DenseSched, 0>(ldsb, DM * 2, S, E);
                }
                SEAM(sb + 3);
            }
            if (PH(5) && MARK(5) && IN(sb + 4)) {
                PHASE_VARS
                unsigned char* slot = ws + WS_WBUF + (size_t)(l & 1) * WSLOT;
                if (DENSE_IS_F8(l)) {
                pg8::DenseSched S{(const char*)proj, (const char*)(slot + WO_DENSE_D), MTOK / 256, DM / 256, G, (int)blockIdx.x, (size_t)256 * DFF};
                pg8::EpiResid<(G1_MODE == 2)> E{hb, rowss + (size_t)(2 * l + 2) * MTOK, ws + WS_HB8, 1.0f / (F8_SACT * F8_SW), rowss + (size_t)(2 * l + 1) * MTOK, nullptr,
                                                  (int*)(ws + WS_XACC) + (size_t)(l + 1) * XSLOT, (const bf16_t*)(ws + WS_WBUF + (size_t)((l + 1) & 1) * WSLOT + WO_WF), (LAS int*)(ldsb + XLDS_OFF)};
                { LAS int* xz = (LAS int*)(ldsb + XLDS_OFF); for (int i = tid; i < 2048; i += 512) xz[i] = 0; __syncthreads(); }
                pg8::gemm_phase<pg8::EpiResid<(G1_MODE == 2)>, pg8::DenseSched, 1>(ldsb, DFF, S, E);
                } else {
                pg8::DenseSched S{(const char*)proj, (const char*)(slot + WO_DENSE_D), MTOK / 256, DM / 256, G, (int)blockIdx.x, (size_t)256 * DFF * 2};
                pg8::EpiResid<false> E{hb, rowss + (size_t)(2 * l + 2) * MTOK, nullptr, 1.0f, nullptr, nullptr, nullptr, nullptr, nullptr};
                pg8::gemm_phase<pg8::EpiResid<false>, pg8::DenseSched, 0>(ldsb, DFF * 2, S, E);
                }
                SEAM(sb + 4);
            }
        } else {
            const LAS int* tab = (const LAS int*)(ldsb + LCTL_OFF) + LC_MOE;
            if (PH(6) && MARK(6) && IN(sb + 3)) { PHASE_VARS router_rows(a, l, ldsb, wave, lane); SEAM(sb + 3); }
            if (PH(7) && MARK(7) && IN(sb + 4)) {
                PHASE_VARS
                unsigned char* slot = ws + WS_WBUF + (size_t)(l & 1) * WSLOT; const int* tokl = (const int*)(ws + WS_TOK);
                moe_tables(a, l, ldsb, 0, 16);
                pg8::MoeSched<true> S{(const char*)(ws + WS_HB8), (const char*)(slot + WO_FFN_GU), tab, tokl, 0, 16, G, (int)blockIdx.x, (size_t)256 * DM, (size_t)256 * DM, (size_t)2048 * DM, (unsigned)DM};
                pg8::EpiSwiglu<true, GU_MODE> E{(unsigned char*)proj, DFE, rowss + (size_t)(2 * l + 1) * MTOK, tokl, rowss + (size_t)(2 * l) * MTOK, (const float*)(ws + WS_WMAX) + (size_t)l * WMAX_LAYER + WMAX_GU, (const float*)(ws + WS_RSL), (const float*)(ws + WS_GATE)};
_Pragma("nounroll") for (int rep = 0; rep < NREP(7); ++rep) pg8::gemm_phase<pg8::EpiSwiglu<true, GU_MODE>, pg8::MoeSched<true>, GU_MODE>(ldsb, DM, S, E);
                SEAM(sb + 4);
            }
            if (PH(8) && MARK(8) && IN(sb + 5)) {
                PHASE_VARS
                unsigned char* slot = ws + WS_WBUF + (size_t)(l & 1) * WSLOT;
                moe_tables_pair(a, l, ldsb);
                pg8::PairSched S{(const char*)proj, (const char*)(slot + WO_MOE_D), tab, (const LAS int*)(ldsb + LCTL_OFF) + LC_PAIR, (const int*)(ws + WS_PREFA), (const int*)(ws + WS_PREFB), G, (int)blockIdx.x, (size_t)256 * DFE, (size_t)DM * DFE, (unsigned)DFE};
                pg8::EpiMoeDown<true> E{hb, rowss + (size_t)(2 * l + 2) * MTOK, (const int*)(ws + WS_PTOK), nullptr, 1.0f / (F8_SACT * F8_SW), ws + WS_HB8, rowss + (size_t)(2 * l + 1) * MTOK,
                                         l + 1 < NLAYER ? (int*)(ws + WS_XACC) + (size_t)(l + 1) * XSLOT : nullptr, (const bf16_t*)(ws + WS_WBUF + (size_t)((l + 1) & 1) * WSLOT + WO_WF), (LAS int*)(ldsb + XLDS_OFF)};
                { LAS int* xz = (LAS int*)(ldsb + XLDS_OFF); for (int i = tid; i < 2048; i += 512) xz[i] = 0; __syncthreads(); }
                pg8::gemm_phase<pg8::EpiMoeDown<true>, pg8::PairSched, 1>(ldsb, DFE, S, E);
                SEAM(sb + 5);
            }
        }
    }
    if (PH(10) && MARK(10) && IN(NSTEP - 1)) { PHASE_VARS final_rows(a, gw, NGW, lane); }
#undef IN
#undef SEAM
#undef PHASE_VARS
}

#ifndef MK_ONE_LAUNCH
#define MK_ONE_LAUNCH 1
#endif
extern "C" void kernel_launch(void* const* d_in, const int* in_sizes, int n_in, void* d_out, int out_size, void* d_ws, size_t ws_size, hipStream_t stream) {
    static int grid = 0;
    if (grid == 0) {
        if (n_in != 18 || in_sizes[0] != MTOK * DM || out_size != MTOK * DM || ws_size < WS_END) { fprintf(stderr, "kernel_launch: shape/workspace mismatch (n_in %d, ws %zu, need %zu); nothing launched\n", n_in, ws_size, (size_t)WS_END); grid = -1; return; }
        int dev = 0, cus = 0, per_cu = 0;
        if (hipGetDevice(&dev) != hipSuccess || hipDeviceGetAttribute(&cus, hipDeviceAttributeMultiprocessorCount, dev) != hipSuccess) { grid = -1; return; }
        if (hipFuncSetAttribute((const void*)fwd, hipFuncAttributeMaxDynamicSharedMemorySize, LDS_BYTES) != hipSuccess) { fprintf(stderr, "kernel_launch: hipFuncSetAttribute failed\n"); grid = -1; return; }
        if (hipOccupancyMaxActiveBlocksPerMultiprocessor(&per_cu, (const void*)fwd, 512, LDS_BYTES) != hipSuccess || per_cu < 1) { fprintf(stderr, "kernel_launch: occupancy query says %d\n", per_cu); }
        (void)hipGetLastError();
        grid = cus;
    }
    if (grid < 0) return;
    if (hipMemsetAsync((char*)d_ws + WS_CTL, 0, CTL_ZERO_BYTES, stream) != hipSuccess) { fprintf(stderr, "kernel_launch: memset failed\n"); return; }
    Args a{};
    a.x = (const float*)d_in[0]; a.attn_norm = (const float*)d_in[1]; a.w_in = (const float*)d_in[2]; a.b_forget = (const float*)d_in[3]; a.fox_q_norm = (const float*)d_in[4];
    a.fox_k_norm = (const float*)d_in[5]; a.sb_out_norm = (const float*)d_in[6]; a.fox_out_norm = (const float*)d_in[7]; a.w_out = (const float*)d_in[8]; a.ffn_norm = (const float*)d_in[9];
    a.dense_w_gate = (const float*)d_in[10]; a.dense_w_up = (const float*)d_in[11]; a.dense_w_down = (const float*)d_in[12]; a.router_w = (const float*)d_in[13]; a.moe_w_gate = (const float*)d_in[14];
    a.moe_w_up = (const float*)d_in[15]; a.moe_w_down = (const float*)d_in[16]; a.final_norm = (const float*)d_in[17]; a.out = (float*)d_out; a.ws = (unsigned char*)d_ws;
#if MK_ONE_LAUNCH
    a.lo = 0; a.hi = NSTEP;
    hipLaunchKernelGGL(fwd, dim3(grid), dim3(512), LDS_BYTES, stream, a);
#else
    for (int s = 0; s < NSTEP; ++s) {
        const int l = (s - 2) / 8, o = (s - 2) % 8;
        if (s >= 2 && s < NSTEP - 1) { if ((l & 1) == 0 && o >= 5) continue; if ((l & 1) == 1 && o >= 7) continue; }
        a.lo = s; a.hi = s + 1;
        hipLaunchKernelGGL(fwd, dim3(grid), dim3(512), LDS_BYTES, stream, a);
    }
#endif
    const hipError_t le = hipPeekAtLastError();
    if (le != hipSuccess) fprintf(stderr, "kernel_launch: launch failed: %s\n", hipGetErrorName(le));
}
```
